# Optimizing an MI355X kernel written in HIP

```python
import math
import jax, jax.numpy as jnp
from jax import lax
import numpy as np

D_MODEL = 2048
BATCH = 4
SEQ = 4096
DEPTH = 1

N_DIFF_HEADS = 6
HEAD_DIM = 128
V_HEAD_DIM = 2 * HEAD_DIM
ATTN_QK_WIDTH = N_DIFF_HEADS * 2 * HEAD_DIM
ATTN_V_WIDTH = N_DIFF_HEADS * V_HEAD_DIM
LAYER_INDEX = 1
LAMBDA_INIT = 0.8 - 0.6 * math.exp(-0.3 * (LAYER_INDEX - 1))
Q_BLOCK = 128

ROPE_THETA = 500000.0
ROT_DIM = HEAD_DIM // 4

N_FOURIER_GROUPS = 4
FOURIER_GROUP_DIM = 128
FOURIER_WIDTH = N_FOURIER_GROUPS * FOURIER_GROUP_DIM

Q_END = ATTN_QK_WIDTH
K_END = Q_END + ATTN_QK_WIDTH
V_END = K_END + ATTN_V_WIDTH
F_END = V_END + FOURIER_WIDTH
GA_END = F_END + D_MODEL
GF_END = GA_END + D_MODEL
IN_WIDTH = GF_END

D_FF = ((8 * D_MODEL // 3 + 255) // 256) * 256

RMS_EPS = 1e-5

kernel_name = "gated_diffattn_fnet_hybrid_block"


def rmsnorm(x, g):
    xf = x.astype(jnp.float32)
    y = xf * lax.rsqrt(jnp.mean(xf * xf, axis=-1, keepdims=True) + RMS_EPS)
    return (y * g.astype(jnp.float32)).astype(x.dtype)


def rope_tables(seq_len, dtype):
    pos = jnp.arange(seq_len, dtype=jnp.float32)
    inv_freq = ROPE_THETA ** (-jnp.arange(0, ROT_DIM, 2, dtype=jnp.float32) / ROT_DIM)
    ang = pos[:, None] * inv_freq[None, :]
    cos = jnp.cos(ang)[None, :, None, None, :].astype(dtype)
    sin = jnp.sin(ang)[None, :, None, None, :].astype(dtype)
    return cos, sin


def partial_rope(x, cos, sin):
    xr, xp = x[..., :ROT_DIM], x[..., ROT_DIM:]
    x1, x2 = xr[..., : ROT_DIM // 2], xr[..., ROT_DIM // 2:]
    rot = jnp.concatenate([x1 * cos - x2 * sin, x2 * cos + x1 * sin], axis=-1)
    return jnp.concatenate([rot, xp], axis=-1)


def diff_attention(q, k, v, lam):
    b, s = q.shape[0], q.shape[1]
    n_blk = s // Q_BLOCK
    scale = 1.0 / math.sqrt(HEAD_DIM)
    qb = jnp.moveaxis(q.reshape(b, n_blk, Q_BLOCK, N_DIFF_HEADS, 2, HEAD_DIM), 1, 0)

    def one_block(qblk):
        sc = jnp.einsum('bqhcd,bkhcd->bhcqk', qblk, k).astype(jnp.float32) * scale
        p = jax.nn.softmax(sc, axis=-1)
        a = (p[:, :, 0] - lam * p[:, :, 1]).astype(v.dtype)
        return jnp.einsum('bhqk,bkhe->bqhe', a, v)

    o = lax.map(one_block, qb)
    return jnp.moveaxis(o, 0, 1).reshape(b, s, N_DIFF_HEADS, V_HEAD_DIM)


def fourier_mix(f):
    ff = jnp.fft.fft2(f.astype(jnp.float32), axes=(1, 3), norm="ortho")
    return jnp.real(ff).astype(f.dtype)


def setup_inputs(seed: int = 0) -> dict:
    key = jax.random.key(seed)
    ks = jax.random.split(key, 16)
    f32 = jnp.float32

    def dense(k, fan_in, fan_out):
        return jax.random.normal(k, (fan_in, fan_out), f32) * fan_in ** -0.5

    return {
        "x": jax.random.normal(ks[0], (BATCH, SEQ, D_MODEL), f32),
        "g_mix": 1.0 + 0.02 * jax.random.normal(ks[1], (D_MODEL,), f32),
        "w_in": dense(ks[2], D_MODEL, IN_WIDTH),
        "lambda_q1": 0.1 * jax.random.normal(ks[3], (HEAD_DIM,), f32),
        "lambda_k1": 0.1 * jax.random.normal(ks[4], (HEAD_DIM,), f32),
        "lambda_q2": 0.1 * jax.random.normal(ks[5], (HEAD_DIM,), f32),
        "lambda_k2": 0.1 * jax.random.normal(ks[6], (HEAD_DIM,), f32),
        "g_subln": 1.0 + 0.02 * jax.random.normal(ks[7], (V_HEAD_DIM,), f32),
        "w_attn_branch": dense(ks[8], ATTN_V_WIDTH, D_MODEL),
        "w_four_branch": dense(ks[9], FOURIER_WIDTH, D_MODEL),
        "w_out": dense(ks[10], D_MODEL, D_MODEL),
        "g_ffn": 1.0 + 0.02 * jax.random.normal(ks[11], (D_MODEL,), f32),
        "w_gate": dense(ks[12], D_MODEL, D_FF),
        "w_up": dense(ks[13], D_MODEL, D_FF),
        "w_down": dense(ks[14], D_FF, D_MODEL),
        "g_final": 1.0 + 0.02 * jax.random.normal(ks[15], (D_MODEL,), f32),
    }


def reference(x, g_mix, w_in, lambda_q1, lambda_k1, lambda_q2, lambda_k2, g_subln,
              w_attn_branch, w_four_branch, w_out, g_ffn, w_gate, w_up, w_down, g_final):
    b, s, _ = x.shape
    cos, sin = rope_tables(s, x.dtype)
    lam = (jnp.exp(jnp.sum(lambda_q1.astype(jnp.float32) * lambda_k1.astype(jnp.float32)))
           - jnp.exp(jnp.sum(lambda_q2.astype(jnp.float32) * lambda_k2.astype(jnp.float32)))
           + LAMBDA_INIT)

    for _ in range(DEPTH):
        h = rmsnorm(x, g_mix)
        z = h @ w_in
        q = z[..., :Q_END].reshape(b, s, N_DIFF_HEADS, 2, HEAD_DIM)
        k = z[..., Q_END:K_END].reshape(b, s, N_DIFF_HEADS, 2, HEAD_DIM)
        v = z[..., K_END:V_END].reshape(b, s, N_DIFF_HEADS, V_HEAD_DIM)
        f = z[..., V_END:F_END].reshape(b, s, N_FOURIER_GROUPS, FOURIER_GROUP_DIM)
        gate_a = jax.nn.sigmoid(z[..., F_END:GA_END])
        gate_f = jax.nn.sigmoid(z[..., GA_END:GF_END])

        q = partial_rope(q, cos, sin)
        k = partial_rope(k, cos, sin)
        o = diff_attention(q, k, v, lam)
        o = rmsnorm(o, g_subln) * (1.0 - LAMBDA_INIT)
        branch_a = o.reshape(b, s, ATTN_V_WIDTH) @ w_attn_branch

        fm = fourier_mix(f).reshape(b, s, FOURIER_WIDTH)
        branch_f = fm @ w_four_branch

        merged = gate_a * branch_a + gate_f * branch_f
        x = x + merged @ w_out

        h2 = rmsnorm(x, g_ffn)
        x = x + (jax.nn.silu(h2 @ w_gate) * (h2 @ w_up)) @ w_down

    return rmsnorm(x, g_final)
```

```cpp
#include <hip/hip_runtime.h>
#include <hip/hip_bf16.h>
#include <hip/hip_cooperative_groups.h>
#include <cstdio>
#include <cstdint>
#include <cmath>
namespace cg = cooperative_groups;
namespace pg8 {
#define PG8_LAS __attribute__((address_space(3)))
typedef unsigned short bf16_t;
typedef short bf16x8 __attribute__((ext_vector_type(8)));
typedef float f32x4 __attribute__((ext_vector_type(4)));
typedef unsigned u32x4 __attribute__((ext_vector_type(4)));
constexpr int BM = 256, BK = 64, HALF = 128, HTB = HALF * BK * 2  , STAGE_BYTES = 8 * HTB, NXCD = 8, WGM = 8;

__host__ __device__ __forceinline__ int lds_byte(int r, int c) { const int st = (r >> 4) * 2 + (c >> 5), rr = r & 15, cc = c & 31, ob = rr * 64 + cc * 2; return st * 1024 + (ob ^ (((ob >> 9) & 1) << 5)); }
__host__ __device__ __forceinline__ void stage_rc(int b, int& R, int& C) { const int st = b / 1024, sb = b % 1024, swz = sb ^ (((sb >> 9) & 1) << 5); R = (st >> 1) * 16 + swz / 64; C = (st & 1) * 32 + (swz % 64) / 2; }
__host__ __device__ __forceinline__ int perm32(int rho) { const int n = rho >> 4, i = rho & 15; return 8 * (i >> 2) + 4 * n + (i & 3); }

struct Unit { int pm, pn; };
struct Gemm { const bf16_t* A; const bf16_t* Bt; int M, N, K; };

struct StaticOrder {
    int nM, nN, nwg, G, c;
    __host__ __device__ void init(int M, int N, int G_, int c_) { nM = M / BM; nN = N / BM; nwg = nM * nN; G = G_; c = c_; }
    __host__ __device__ bool next(int i, Unit& u) const {
        const long L = (long)i * G + c; if (L >= nwg) return false;
        int wgid = (int)L; { const int q = nwg / NXCD, r = nwg % NXCD, xcd = wgid % NXCD, off = wgid / NXCD; wgid = (xcd < r ? xcd * (q + 1) : r * (q + 1) + (xcd - r) * q) + off; }
        const int nig = WGM * nN, gid = wgid / nig, fm = gid * WGM, gsz = (nM - fm) < WGM ? (nM - fm) : WGM;
        u.pm = fm + ((wgid % nig) % gsz); u.pn = (wgid % nig) / gsz; return true;
    }
    __device__ __forceinline__ void a_ready(const Unit&) const {}
    __device__ __forceinline__ void done(const Unit&) const {}
};
typedef float cvt_f32x2_t __attribute__((ext_vector_type(2))); typedef __bf16 cvt_bf16x2_t __attribute__((ext_vector_type(2)));
__device__ __forceinline__ unsigned cvt_pk_bf16(float lo, float hi) { cvt_f32x2_t v = {lo, hi}; cvt_bf16x2_t b = __builtin_convertvector(v, cvt_bf16x2_t); return __builtin_bit_cast(unsigned, b); }
typedef float f32x2 __attribute__((ext_vector_type(2)));
typedef unsigned u32x2 __attribute__((ext_vector_type(2)));
__device__ __forceinline__ float bflo(unsigned w) { return __uint_as_float(w << 16); }
__device__ __forceinline__ float bfhi(unsigned w) { return __uint_as_float(w & 0xffff0000u); }
__device__ __forceinline__ float sigmoidf_fast(float v) { return __builtin_amdgcn_rcpf(1.0f + __builtin_amdgcn_exp2f(-1.4426950408889634f * v)); }
__device__ __forceinline__ u32x4 pack8(const f32x4 v0, const f32x4 v1) { u32x4 w; w.x = cvt_pk_bf16(v0[0], v0[1]); w.y = cvt_pk_bf16(v0[2], v0[3]); w.z = cvt_pk_bf16(v1[0], v1[1]); w.w = cvt_pk_bf16(v1[2], v1[3]); return w; }

struct EpiZ {
    static constexpr bool PERM = true, AFTER_DRAIN = false;
    bf16_t *Q, *K, *V, *FT, *GA, *GF; const float* inv_rms; const float* rope;
    __device__ __forceinline__ void operator()(const f32x4 (&acc)[2][2][4][2], const Unit& u, int wr, int wc, int fr, int fq) const {
        const int pn = u.pn, row0 = u.pm * BM + wr * 64 + fr, cl0 = wc * 32 + 8 * fq;
        if (pn < 12) {
            bf16_t* base = (pn < 6 ? Q : K) + (pn % 6) * 256 + cl0;
#pragma unroll
            for (int ai = 0; ai < 2; ++ai)
#pragma unroll
                for (int m = 0; m < 4; ++m) {
                    const int row = row0 + ai * HALF + m * 16; const float rs = inv_rms[row];
                    f32x4 cs[4];
                    if (wc == 0) { const f32x4* rp = (const f32x4*)(rope + (size_t)(row & 4095) * 32 + (fq & 1) * 16);
#pragma unroll
                        for (int t = 0; t < 4; ++t) cs[t] = rp[t]; }
#pragma unroll
                    for (int bj = 0; bj < 2; ++bj) {
                        f32x4 v0 = acc[ai][bj][m][0] * rs, v1 = acc[ai][bj][m][1] * rs;
                        if (wc == 0) {
                            const float sg = (fq < 2) ? -1.f : 1.f;
#pragma unroll
                            for (int i = 0; i < 4; ++i) {
                                const float p0 = __shfl_xor(v0[i], 32), p1 = __shfl_xor(v1[i], 32);
                                const float c0 = cs[i >> 1][(i & 1) * 2], s0 = cs[i >> 1][(i & 1) * 2 + 1];
                                const float c1 = cs[2 + (i >> 1)][(i & 1) * 2], s1 = cs[2 + (i >> 1)][(i & 1) * 2 + 1];
                                v0[i] = v0[i] * c0 + sg * p0 * s0; v1[i] = v1[i] * c1 + sg * p1 * s1;
                            }
                        }
                        *(u32x4*)(base + (size_t)row * 1536 + bj * HALF) = pack8(v0, v1);
                    }
                }
        } else if (pn < 18) {
            bf16_t* base = V + (pn - 12) * 256 + cl0;
#pragma unroll
            for (int ai = 0; ai < 2; ++ai)
#pragma unroll
                for (int m = 0; m < 4; ++m) { const int row = row0 + ai * HALF + m * 16; const float rs = inv_rms[row];
#pragma unroll
                    for (int bj = 0; bj < 2; ++bj) *(u32x4*)(base + (size_t)row * 1536 + bj * HALF) = pack8(acc[ai][bj][m][0] * rs, acc[ai][bj][m][1] * rs); }
        } else if (pn < 20) {
            bf16_t* base = FT + (pn - 18) * 256 + cl0;
#pragma unroll
            for (int ai = 0; ai < 2; ++ai)
#pragma unroll
                for (int m = 0; m < 4; ++m) { const int row = row0 + ai * HALF + m * 16; const float rs = inv_rms[row];
#pragma unroll
                    for (int bj = 0; bj < 2; ++bj) *(u32x4*)(base + (size_t)row * 512 + bj * HALF) = pack8(acc[ai][bj][m][0] * rs, acc[ai][bj][m][1] * rs); }
        } else {
            bf16_t* base = (pn < 28 ? GA + (pn - 20) * 256 : GF + (pn - 28) * 256) + cl0;
#pragma unroll
            for (int ai = 0; ai < 2; ++ai)
#pragma unroll
                for (int m = 0; m < 4; ++m) { const int row = row0 + ai * HALF + m * 16; const float rs = inv_rms[row];
#pragma unroll
                    for (int bj = 0; bj < 2; ++bj) { f32x4 v0 = acc[ai][bj][m][0] * rs, v1 = acc[ai][bj][m][1] * rs;
#pragma unroll
                        for (int i = 0; i < 4; ++i) { v0[i] = sigmoidf_fast(v0[i]); v1[i] = sigmoidf_fast(v1[i]); }
                        *(u32x4*)(base + (size_t)row * 2048 + bj * HALF) = pack8(v0, v1); } }
        }
    }
};

struct EpiDft {
    static constexpr bool PERM = true, AFTER_DRAIN = false;
    bf16_t* G;
    __device__ __forceinline__ void operator()(const f32x4 (&acc)[2][2][4][2], const Unit& u, int wr, int wc, int fr, int fq) const {
        const int part = u.pm >> 3, parity = (u.pm >> 2) & 1, kk0 = (u.pm & 3) * BM + wr * 64 + fr, pn = u.pn & 7, b = pn >> 1, col0 = part * 512 + (pn & 1) * 256 + wc * 32 + 8 * fq;
        const unsigned sgn = part ? 0x80008000u : 0u;
#pragma unroll
        for (int ai = 0; ai < 2; ++ai)
#pragma unroll
            for (int m = 0; m < 4; ++m) { const int k = 2 * (kk0 + ai * HALF + m * 16) + parity; const size_t row = (size_t)b * 4096 + k, rowm = (size_t)b * 4096 + (4096 - k);
#pragma unroll
                for (int bj = 0; bj < 2; ++bj) { const u32x4 w = pack8(acc[ai][bj][m][0], acc[ai][bj][m][1]);
                    *(u32x4*)(G + row * 1024 + col0 + bj * HALF) = w;
                    if (k > 0) { u32x4 wm; wm.x = w.x ^ sgn; wm.y = w.y ^ sgn; wm.z = w.z ^ sgn; wm.w = w.w ^ sgn; *(u32x4*)(G + rowm * 1024 + col0 + bj * HALF) = wm; } } }
    }
};
struct DftOrder {
    StaticOrder S0;
    __device__ __forceinline__ bool next(int i, Unit& u) const { if (!S0.next(i, u)) return false; u.pn += 8 * ((u.pm >> 2) & 1); return true; }
    __device__ __forceinline__ void a_ready(const Unit&) const {}
    __device__ __forceinline__ void done(const Unit&) const {}
};

struct EpiGateA {
    static constexpr bool PERM = true, AFTER_DRAIN = false;
    const bf16_t* GA; bf16_t* P1;
    __device__ __forceinline__ void operator()(const f32x4 (&acc)[2][2][4][2], const Unit& u, int wr, int wc, int fr, int fq) const {
        const int row0 = u.pm * BM + wr * 64 + fr, col0 = u.pn * BM + wc * 32 + 8 * fq;
#pragma unroll
        for (int ai = 0; ai < 2; ++ai)
#pragma unroll
            for (int m = 0; m < 4; ++m)
#pragma unroll
                for (int bj = 0; bj < 2; ++bj) { const size_t off = (size_t)(row0 + ai * HALF + m * 16) * 2048 + col0 + bj * HALF;
                    const u32x4 g = *(const u32x4*)(GA + off); const f32x4 a0 = acc[ai][bj][m][0], a1 = acc[ai][bj][m][1]; u32x4 w;
                    w.x = cvt_pk_bf16(a0[0] * bflo(g.x), a0[1] * bfhi(g.x)); w.y = cvt_pk_bf16(a0[2] * bflo(g.y), a0[3] * bfhi(g.y));
                    w.z = cvt_pk_bf16(a1[0] * bflo(g.z), a1[1] * bfhi(g.z)); w.w = cvt_pk_bf16(a1[2] * bflo(g.w), a1[3] * bfhi(g.w));
                    *(u32x4*)(P1 + off) = w; }
    }
};
struct EpiGateF {
    static constexpr bool PERM = true, AFTER_DRAIN = false;
    const bf16_t* GF; const bf16_t* P1; bf16_t* MG;
    __device__ __forceinline__ void operator()(const f32x4 (&acc)[2][2][4][2], const Unit& u, int wr, int wc, int fr, int fq) const {
        const int row0 = u.pm * BM + wr * 64 + fr, col0 = u.pn * BM + wc * 32 + 8 * fq;
#pragma unroll
        for (int ai = 0; ai < 2; ++ai)
#pragma unroll
            for (int m = 0; m < 4; ++m)
#pragma unroll
                for (int bj = 0; bj < 2; ++bj) { const size_t off = (size_t)(row0 + ai * HALF + m * 16) * 2048 + col0 + bj * HALF;
                    const u32x4 g = *(const u32x4*)(GF + off); const u32x4 p = *(const u32x4*)(P1 + off); const f32x4 a0 = acc[ai][bj][m][0], a1 = acc[ai][bj][m][1]; u32x4 w;
                    w.x = cvt_pk_bf16(bflo(p.x) + a0[0] * bflo(g.x), bfhi(p.x) + a0[1] * bfhi(g.x)); w.y = cvt_pk_bf16(bflo(p.y) + a0[2] * bflo(g.y), bfhi(p.y) + a0[3] * bfhi(g.y));
                    w.z = cvt_pk_bf16(bflo(p.z) + a1[0] * bflo(g.z), bfhi(p.z) + a1[1] * bfhi(g.z)); w.w = cvt_pk_bf16(bflo(p.w) + a1[2] * bflo(g.w), bfhi(p.w) + a1[3] * bfhi(g.w));
                    *(u32x4*)(MG + off) = w; }
    }
};
template <bool WITH_XG> struct EpiRes {
    static constexpr bool PERM = false, AFTER_DRAIN = false;
    const float* base; float* out; bf16_t* xg; const float* gvec; float* rowss;
    __device__ __forceinline__ void operator()(const f32x4 (&acc)[2][2][4][2], const Unit& u, int wr, int wc, int fr, int fq) const {
        const int row0 = u.pm * BM + wr * 64 + fr, col0 = u.pn * BM + wc * 32 + 4 * fq;
        f32x4 gv[2][2];
        if (WITH_XG) {
#pragma unroll
            for (int bj = 0; bj < 2; ++bj)
#pragma unroll
                for (int n = 0; n < 2; ++n) gv[bj][n] = *(const f32x4*)(gvec + col0 + bj * HALF + n * 16); }
#pragma unroll
        for (int ai = 0; ai < 2; ++ai)
#pragma unroll
            for (int m = 0; m < 4; ++m) { const int row = row0 + ai * HALF + m * 16; const size_t off = (size_t)row * 2048 + col0; float ss = 0.f;
#pragma unroll
                for (int bj = 0; bj < 2; ++bj)
#pragma unroll
                    for (int n = 0; n < 2; ++n) { const f32x4 v = *(const f32x4*)(base + off + bj * HALF + n * 16) + acc[ai][bj][m][n];
                        *(f32x4*)(out + off + bj * HALF + n * 16) = v; ss += (v[0] * v[0] + v[1] * v[1]) + (v[2] * v[2] + v[3] * v[3]);
                        if (WITH_XG) { const f32x4 t = v * gv[bj][n]; u32x2 w; w.x = cvt_pk_bf16(t[0], t[1]); w.y = cvt_pk_bf16(t[2], t[3]); *(u32x2*)(xg + off + bj * HALF + n * 16) = w; } }
                ss += __shfl_xor(ss, 16); ss += __shfl_xor(ss, 32);
                if (fq == 0) atomicAdd(rowss + row, ss); }
    }
};
struct EpiSwiGLU {
    static constexpr bool PERM = true, AFTER_DRAIN = false;
    bf16_t* U; const float* rowss;
    __device__ __forceinline__ void operator()(const f32x4 (&acc)[2][2][4][2], const Unit& u, int wr, int wc, int fr, int fq) const {
        const int row0 = u.pm * BM + wr * 64 + fr, ucol0 = u.pn * 128 + wc * 16 + 4 * fq;
#pragma unroll
        for (int ai = 0; ai < 2; ++ai)
#pragma unroll
            for (int m = 0; m < 4; ++m) { const int row = row0 + ai * HALF + m * 16; const float rs = __builtin_amdgcn_rsqf(rowss[row] * (1.0f / 2048.0f) + 1e-5f);
#pragma unroll
                for (int bj = 0; bj < 2; ++bj) { const f32x4 g = acc[ai][bj][m][0] * rs, up = acc[ai][bj][m][1] * rs; f32x4 s;
#pragma unroll
                    for (int i = 0; i < 4; ++i) s[i] = g[i] * sigmoidf_fast(g[i]) * up[i];
                    u32x2 w; w.x = cvt_pk_bf16(s[0], s[1]); w.y = cvt_pk_bf16(s[2], s[3]);
                    *(u32x2*)(U + (size_t)row * 5632 + ucol0 + bj * 64) = w; } }
    }
};

template <class Epi, class Sched, bool ALIGN_EPI = false, bool SP2 = false>
__device__ __forceinline__ void gemm_phase(PG8_LAS unsigned char* lds, const Gemm g, const Sched& S, const Epi& E) {
    int tid_ = threadIdx.x; asm volatile("" : "+v"(tid_));
    const int tid = tid_, wid = __builtin_amdgcn_readfirstlane(tid >> 6), lane = tid & 63, wr = wid >> 2, wc = wid & 3, fr = lane & 15, fq = lane >> 4;
    const int K = g.K, nt = K / BK;
    unsigned voffA[2], voffB[2];
#pragma unroll
    for (int i = 0; i < 2; ++i) { int R, C; stage_rc(tid * 16 + i * 8192, R, C); const int Rb = Epi::PERM ? ((R & ~31) + perm32(R & 31)) : R;
        voffA[i] = (unsigned)(R * K + C) * 2u; voffB[i] = (unsigned)(Rb * K + C) * 2u; }
    const size_t kstep = (size_t)(BK * 2);
    const size_t hstep = (size_t)HALF * K * 2;
    const size_t tstep = 2 * hstep;
    const unsigned ldsw = (unsigned)wid * 1024u;
    const int aoff = lds_byte(wr * 64 + fr, fq * 8), boff = lds_byte(wc * 32 + fr, fq * 8);
#define PG8_SA(b, h) (((b) * 2 + (h)) * HTB)
#define PG8_SB(b, h) ((4 + (b) * 2 + (h)) * HTB)
#define PG8_STAGE(bufoff, gbase, voff) do { _Pragma("unroll") for (int _i = 0; _i < 2; ++_i) \
        __builtin_amdgcn_global_load_lds((const unsigned*)((const char*)(gbase) + (voff)[_i]), (PG8_LAS unsigned*)(lds + (bufoff) + ldsw + _i * 8192), 16, 0, 0); } while (0)
#define PG8_LDA(dst, b, h) do { _Pragma("unroll") for (int m = 0; m < 4; ++m) _Pragma("unroll") for (int k = 0; k < 2; ++k) dst[m][k] = *(const PG8_LAS bf16x8*)(lds + PG8_SA(b, h) + aoff + m * 2048 + k * 1024); } while (0)
#define PG8_LDB(dst, b, h) do { _Pragma("unroll") for (int n = 0; n < 2; ++n) _Pragma("unroll") for (int k = 0; k < 2; ++k) dst[n][k] = *(const PG8_LAS bf16x8*)(lds + PG8_SB(b, h) + boff + n * 2048 + k * 1024); } while (0)
#define PG8_MMA(ai, bj, At, Bt) do { __builtin_amdgcn_s_setprio(1); _Pragma("unroll") for (int m = 0; m < 4; ++m) _Pragma("unroll") for (int n = 0; n < 2; ++n) _Pragma("unroll") for (int k = 0; k < 2; ++k) \
        acc[ai][bj][m][n] = __builtin_amdgcn_mfma_f32_16x16x32_bf16(Bt[n][k], At[m][k], acc[ai][bj][m][n], 0, 0, 0); __builtin_amdgcn_s_setprio(0); } while (0)
#define PG8_WAIT_V(n) asm volatile("s_waitcnt vmcnt(" #n ")" ::: "memory")
#define PG8_WAIT_L(n) asm volatile("s_waitcnt lgkmcnt(" #n ")" ::: "memory")
#define PG8_BAR __builtin_amdgcn_s_barrier()
#define PG8_SCHED __builtin_amdgcn_sched_barrier(0)
    Unit cur, nxt; int ui = 0;
    if (!S.next(0, cur)) return;
    f32x4 acc[2][2][4][2];
#pragma unroll
    for (int a = 0; a < 2; ++a)
#pragma unroll
        for (int b = 0; b < 2; ++b)
#pragma unroll
            for (int m = 0; m < 4; ++m)
#pragma unroll
                for (int n = 0; n < 2; ++n) acc[a][b][m][n] = (f32x4){0.f, 0.f, 0.f, 0.f};
    bf16x8 At[4][2], B0[2][2], B1[2][2];
    const char* cA = (const char*)g.A + (size_t)cur.pm * tstep; const char* cB = (const char*)g.Bt + (size_t)cur.pn * tstep;
    S.a_ready(cur);
    if constexpr (SP2) {
        PG8_STAGE(PG8_SB(0, 0), cB, voffB); PG8_STAGE(PG8_SB(0, 1), cB + hstep, voffB); PG8_STAGE(PG8_SA(0, 0), cA, voffA); PG8_STAGE(PG8_SA(0, 1), cA + hstep, voffA);
        if (wr == 1) PG8_BAR;
        PG8_WAIT_V(2); PG8_BAR;
        PG8_STAGE(PG8_SB(1, 0), cB + kstep, voffB); PG8_STAGE(PG8_SA(1, 0), cA + kstep, voffA); PG8_STAGE(PG8_SB(1, 1), cB + hstep + kstep, voffB);
        PG8_WAIT_V(6); PG8_BAR;
    } else {
        PG8_STAGE(PG8_SB(0, 0), cB, voffB); PG8_STAGE(PG8_SA(0, 0), cA, voffA); PG8_STAGE(PG8_SB(0, 1), cB + hstep, voffB); PG8_STAGE(PG8_SA(0, 1), cA + hstep, voffA);
        if (wr == 1) PG8_BAR;
        PG8_WAIT_V(4); PG8_BAR;
        PG8_STAGE(PG8_SB(1, 0), cB + kstep, voffB); PG8_STAGE(PG8_SA(1, 0), cA + kstep, voffA); PG8_STAGE(PG8_SB(1, 1), cB + hstep + kstep, voffB);
        PG8_WAIT_V(6); PG8_BAR;
    }
    for (;;) {
        const bool has_next = S.next(ui + 1, nxt);
        const char* nA = has_next ? (const char*)g.A + (size_t)nxt.pm * tstep : cA; const char* nB = has_next ? (const char*)g.Bt + (size_t)nxt.pn * tstep : cB;
        for (int t = 0; t < nt; t += 2) {
            const bool last = (t == nt - 2);
            const char* a1 = cA + (size_t)(t + 1) * kstep;
            const char* a2 = last ? nA : cA + (size_t)(t + 2) * kstep; const char* b2 = last ? nB : cB + (size_t)(t + 2) * kstep;
            const char* a3 = a2 + kstep; const char* b3 = b2 + kstep;
            if (last && has_next) S.a_ready(nxt);
            if constexpr (SP2) {
            PG8_LDB(B0, 0, 0); PG8_LDB(B1, 0, 1); PG8_SCHED; PG8_LDA(At, 0, 0); PG8_STAGE(PG8_SA(1, 1), a1 + hstep, voffA);
            PG8_WAIT_V(8); PG8_WAIT_L(0); PG8_BAR; PG8_MMA(0, 0, At, B0); PG8_MMA(0, 1, At, B1); PG8_BAR; PG8_SCHED;
            PG8_LDA(At, 0, 1); PG8_STAGE(PG8_SB(0, 0), b2, voffB); PG8_STAGE(PG8_SB(0, 1), b2 + hstep, voffB); PG8_STAGE(PG8_SA(0, 0), a2, voffA);
            PG8_WAIT_V(8); PG8_WAIT_L(0); PG8_BAR; PG8_MMA(1, 0, At, B0); PG8_MMA(1, 1, At, B1); PG8_BAR; PG8_SCHED;
            PG8_LDB(B0, 1, 0); PG8_LDB(B1, 1, 1); PG8_SCHED; PG8_LDA(At, 1, 0); PG8_STAGE(PG8_SA(0, 1), a2 + hstep, voffA);
            PG8_WAIT_V(8); PG8_WAIT_L(0); PG8_BAR; PG8_MMA(0, 0, At, B0); PG8_MMA(0, 1, At, B1); PG8_BAR; PG8_SCHED;
            PG8_LDA(At, 1, 1); PG8_STAGE(PG8_SB(1, 0), b3, voffB); PG8_STAGE(PG8_SB(1, 1), b3 + hstep, voffB); PG8_STAGE(PG8_SA(1, 0), a3, voffA);
            PG8_WAIT_V(8); PG8_WAIT_L(0); PG8_BAR; PG8_MMA(1, 0, At, B0); PG8_MMA(1, 1, At, B1); PG8_BAR; PG8_SCHED;
            } else {
            PG8_LDB(B0, 0, 0); PG8_SCHED; PG8_LDA(At, 0, 0); PG8_STAGE(PG8_SA(1, 1), a1 + hstep, voffA);
            PG8_WAIT_L(8); PG8_BAR; PG8_WAIT_L(0); PG8_MMA(0, 0, At, B0); PG8_BAR; PG8_SCHED;
            PG8_LDB(B1, 0, 1); PG8_STAGE(PG8_SB(0, 0), b2, voffB);
            PG8_BAR; PG8_WAIT_L(0); PG8_MMA(0, 1, At, B1); PG8_BAR;
            PG8_LDA(At, 0, 1); PG8_STAGE(PG8_SA(0, 0), a2, voffA);
            PG8_BAR; PG8_WAIT_L(0); PG8_MMA(1, 0, At, B0); PG8_BAR; PG8_SCHED;
            PG8_STAGE(PG8_SB(0, 1), b2 + hstep, voffB);
            PG8_WAIT_V(6); PG8_BAR; PG8_MMA(1, 1, At, B1); PG8_BAR;
            PG8_LDB(B0, 1, 0); PG8_SCHED; PG8_LDA(At, 1, 0); PG8_STAGE(PG8_SA(0, 1), a2 + hstep, voffA);
            PG8_WAIT_L(8); PG8_BAR; PG8_WAIT_L(0); PG8_MMA(0, 0, At, B0); PG8_BAR; PG8_SCHED;
            PG8_LDB(B1, 1, 1); PG8_STAGE(PG8_SB(1, 0), b3, voffB);
            PG8_BAR; PG8_WAIT_L(0); PG8_MMA(0, 1, At, B1); PG8_BAR;
            PG8_LDA(At, 1, 1); PG8_STAGE(PG8_SA(1, 0), a3, voffA);
            PG8_BAR; PG8_WAIT_L(0); PG8_MMA(1, 0, At, B0); PG8_BAR; PG8_SCHED;
            PG8_STAGE(PG8_SB(1, 1), b3 + hstep, voffB);
            PG8_WAIT_V(6); PG8_BAR; PG8_MMA(1, 1, At, B1); PG8_BAR;
            }
        }
        if constexpr (ALIGN_EPI) { if (wr == 0) PG8_BAR; }
        if constexpr (!Epi::AFTER_DRAIN) { E(acc, cur, wr, wc, fr, fq); S.done(cur); }
        if (!has_next) break;
#pragma unroll
        for (int a = 0; a < 2; ++a)
#pragma unroll
            for (int b = 0; b < 2; ++b)
#pragma unroll
                for (int m = 0; m < 4; ++m)
#pragma unroll
                    for (int n = 0; n < 2; ++n) acc[a][b][m][n] = (f32x4){0.f, 0.f, 0.f, 0.f};
        cur = nxt; cA = nA; cB = nB; ++ui;
        if constexpr (ALIGN_EPI) { if (wr == 1) PG8_BAR; }
    }
    PG8_WAIT_V(0);
    if constexpr (!ALIGN_EPI) { if (wr == 0) PG8_BAR; }
    PG8_BAR;
    if constexpr (Epi::AFTER_DRAIN) { E.fused(acc, cur, wr, wc, fr, fq, lds, wid, lane); S.done(cur); }
#undef PG8_SA
#undef PG8_SB
#undef PG8_STAGE
#undef PG8_LDA
#undef PG8_LDB
#undef PG8_MMA
#undef PG8_WAIT_V
#undef PG8_WAIT_L
#undef PG8_BAR
#undef PG8_SCHED
}
}

namespace att {
using bf16 = __hip_bfloat16;
constexpr int   D = 128, NW = 8, QBLK = 32, KVBLK = 64;
constexpr float SCALE = 0.088388347648318440f;
constexpr float THR = 8.f;
#ifndef ATT_SDEPTH
#define ATT_SDEPTH 2
#endif
constexpr int SDEPTH = ATT_SDEPTH;
constexpr int LDQ = 1536, LDK = 1536, LDO = 3072;
constexpr size_t SHM_V = KVBLK * D * 2, SHM_K = KVBLK * D * 2, SHM_ATTN = 2 * SHM_V + 2 * SHM_K + NW * 64 * 4;
using bf16x8 = __attribute__((ext_vector_type(8))) short;
using s16x4  = __attribute__((ext_vector_type(4))) short;
using f32x16 = __attribute__((ext_vector_type(16))) float;
using f32x8  = __attribute__((ext_vector_type(8))) float;
using u32x4  = __attribute__((ext_vector_type(4))) unsigned;
#define KSWZ(row, colB) ((row) * 256 + ((colB) ^ (((row) & 7) << 4)))
#define SBAR() __builtin_amdgcn_sched_barrier(0)
__device__ __forceinline__ int crow(int r, int hi) { return (r & 3) + 8 * (r >> 2) + 4 * hi; }
typedef float cvt_f32x2_t __attribute__((ext_vector_type(2))); typedef __bf16 cvt_bf16x2_t __attribute__((ext_vector_type(2)));
__device__ __forceinline__ unsigned cvtpk(float lo, float hi) {
  cvt_f32x2_t v = {lo, hi}; cvt_bf16x2_t b = __builtin_convertvector(v, cvt_bf16x2_t); return __builtin_bit_cast(unsigned, b);
}
template <typename TIn> struct Stage;
template <> struct Stage<bf16>  { using T = bf16x8;
  __device__ static __forceinline__ T ld8(const bf16* p) { return *reinterpret_cast<const bf16x8*>(p); }
  __device__ static __forceinline__ bf16x8 tobf(T x) { return x; } };
template <> struct Stage<float> { using T = f32x8;
  __device__ static __forceinline__ T ld8(const float* p) { return *reinterpret_cast<const f32x8*>(p); }
  __device__ static __forceinline__ bf16x8 tobf(T x) {
    u32x4 w = {cvtpk(x[0], x[1]), cvtpk(x[2], x[3]), cvtpk(x[4], x[5]), cvtpk(x[6], x[7])}; return *reinterpret_cast<bf16x8*>(&w); } };

__device__ __forceinline__ void partialSM(f32x16& p0, f32x16& p1, float& m_reg, float& mn, float& alpha) {
  constexpr float C = SCALE * 1.4426950408889634f;
  float pmax = p0[0]; for (int r = 1; r < 16; ++r) pmax = fmaxf(pmax, p0[r]); for (int r = 0; r < 16; ++r) pmax = fmaxf(pmax, p1[r]);
  { auto rr = __builtin_amdgcn_permlane32_swap(__float_as_uint(pmax), __float_as_uint(pmax), false, false);
    pmax = fmaxf(__uint_as_float(rr[0]), __uint_as_float(rr[1])); }
  if (__builtin_expect(__all(pmax - m_reg <= THR / SCALE), 1)) { mn = m_reg; alpha = 1.f; }
  else { mn = fmaxf(m_reg, pmax); alpha = __builtin_amdgcn_exp2f((m_reg - mn) * C); m_reg = mn; }
  float mnC = -mn * C;
  for (int r = 0; r < 16; ++r) p0[r] = fmaf(p0[r], C, mnC); for (int r = 0; r < 16; ++r) p1[r] = fmaf(p1[r], C, mnC);
  for (int r = 0; r < 16; ++r) p0[r] = __builtin_amdgcn_exp2f(p0[r]);
}
__device__ __forceinline__ void finishSM(f32x16& p0, f32x16& p1, float alpha, float& l_reg, bf16x8& pa0, bf16x8& pa1, bf16x8& pa2, bf16x8& pa3) {
  for (int r = 0; r < 16; ++r) p1[r] = __builtin_amdgcn_exp2f(p1[r]);
  float ps = 0; for (int r = 0; r < 16; ++r) ps += p0[r]; for (int r = 0; r < 16; ++r) ps += p1[r];
  { auto rr = __builtin_amdgcn_permlane32_swap(__float_as_uint(ps), __float_as_uint(ps), false, false);
    ps = __uint_as_float(rr[0]) + __uint_as_float(rr[1]); }
  l_reg = l_reg * alpha + ps;
#define PK4(P, BASE, OUT) do { unsigned a0 = cvtpk(P[BASE + 0], P[BASE + 1]), a1 = cvtpk(P[BASE + 2], P[BASE + 3]);   \
    unsigned b0 = cvtpk(P[BASE + 4], P[BASE + 5]), b1 = cvtpk(P[BASE + 6], P[BASE + 7]);                              \
    auto r0 = __builtin_amdgcn_permlane32_swap(a0, b0, false, false); auto r1 = __builtin_amdgcn_permlane32_swap(a1, b1, false, false); \
    u32x4 w = {r0[0], r1[0], r0[1], r1[1]}; OUT = *reinterpret_cast<bf16x8*>(&w); } while (0)
  PK4(p0, 0, pa0); PK4(p0, 8, pa1); PK4(p1, 0, pa2); PK4(p1, 8, pa3);
#undef PK4
}
__device__ __forceinline__ void qkt(f32x16& p0, f32x16& p1, const bf16* Ks, const bf16x8* qr, int r32, int hi) {
  p0 = f32x16{}; p1 = f32x16{};
  for (int d0 = 0; d0 < 8; ++d0) { int cb = (d0 * 16 + hi * 8) * 2;
    bf16x8 b0 = *reinterpret_cast<const bf16x8*>((const char*)Ks + KSWZ(r32, cb));
    bf16x8 b1 = *reinterpret_cast<const bf16x8*>((const char*)Ks + KSWZ(32 + r32, cb));
    p0 = __builtin_amdgcn_mfma_f32_32x32x16_bf16(b0, qr[d0], p0, 0, 0, 0);
    p1 = __builtin_amdgcn_mfma_f32_32x32x16_bf16(b1, qr[d0], p1, 0, 0, 0); }
}
__device__ __forceinline__ int v_st(int k, int c) { const int kk = (k & ~0xC) | ((k & 4) << 1) | ((k & 8) >> 1); return ((kk >> 3) * 4 + (c >> 5)) * 512 + ((kk & 7) * 32 + (c & 31)) * 2; }
__device__ __forceinline__ int v_rd_base(int lane) { return ((lane & 3) << 3) | (((lane >> 2) & 3) << 6) | (((lane >> 4) & 1) << 5) | (((lane >> 5) & 1) << 8); }
constexpr int v_rd_off(int d0, int ks, int half) { return d0 * 512 + ks * 4096 + half * 2048; }
template <int OFF> __device__ __forceinline__ s16x4 tr_read(int vb) {
  s16x4 r; asm volatile("ds_read_b64_tr_b16 %0, %1 offset:%2" : "=&v"(r) : "v"(vb), "i"(OFF) : "memory"); return r;
}
template <int D0> __device__ __forceinline__ void pv_one(f32x16& od, int vb, bf16x8 pa0, bf16x8 pa1, bf16x8 pa2, bf16x8 pa3) {
  const s16x4 l0 = tr_read<v_rd_off(D0, 0, 0)>(vb), h0 = tr_read<v_rd_off(D0, 0, 1)>(vb), l1 = tr_read<v_rd_off(D0, 1, 0)>(vb), h1 = tr_read<v_rd_off(D0, 1, 1)>(vb);
  const s16x4 l2 = tr_read<v_rd_off(D0, 2, 0)>(vb), h2 = tr_read<v_rd_off(D0, 2, 1)>(vb), l3 = tr_read<v_rd_off(D0, 3, 0)>(vb), h3 = tr_read<v_rd_off(D0, 3, 1)>(vb);
  asm volatile("s_waitcnt lgkmcnt(0)" ::: "memory"); SBAR();
#define PK(L, H) (bf16x8){L[0], L[1], L[2], L[3], H[0], H[1], H[2], H[3]}
  od = __builtin_amdgcn_mfma_f32_32x32x16_bf16(pa0, PK(l0, h0), od, 0, 0, 0);
  od = __builtin_amdgcn_mfma_f32_32x32x16_bf16(pa1, PK(l1, h1), od, 0, 0, 0);
  od = __builtin_amdgcn_mfma_f32_32x32x16_bf16(pa2, PK(l2, h2), od, 0, 0, 0);
  od = __builtin_amdgcn_mfma_f32_32x32x16_bf16(pa3, PK(l3, h3), od, 0, 0, 0);
#undef PK
}
__device__ __forceinline__ void pv_d0(f32x16* o, int vb, bf16x8 pa0, bf16x8 pa1, bf16x8 pa2, bf16x8 pa3) {
  pv_one<0>(o[0], vb, pa0, pa1, pa2, pa3); pv_one<1>(o[1], vb, pa0, pa1, pa2, pa3); pv_one<2>(o[2], vb, pa0, pa1, pa2, pa3); pv_one<3>(o[3], vb, pa0, pa1, pa2, pa3);
}
template <typename TQ>
__device__ __forceinline__ void attn_dense_body(const TQ* __restrict__ Qb, const bf16* __restrict__ Kh, const bf16* __restrict__ Vh,
                                                bf16* __restrict__ Ob, int seq, char* lds) {
  using St = Stage<bf16>; using SQ = Stage<TQ>;
  int tid_ = threadIdx.x; asm volatile("" : "+v"(tid_));
  const int tid = tid_, wid = tid >> 6, lane = tid & 63, r32 = lane & 31, hi = lane >> 5;
  bf16* V_lds = (bf16*)lds; bf16* K_lds = (bf16*)(lds + 2 * SHM_V);
  float* ws = (float*)(lds + 2 * SHM_V + 2 * SHM_K) + wid * 64; float* li_l = ws; float* al_l = ws + 32;
  float m_reg = -1e30f, l_reg = 0; f32x16 o[4] = {}; bf16x8 qr[8];
  const TQ* Qw = Qb + (long)(wid * QBLK + r32) * LDQ + hi * 8;
#pragma unroll
  for (int d0 = 0; d0 < 8; ++d0) qr[d0] = SQ::tobf(SQ::ld8(Qw + d0 * 16));
  const int sr = tid >> 4, sc = (tid & 15) * 8, vst0 = v_st(sr, sc), vst1 = v_st(32 + sr, sc);
  const int vb0 = (int)(uintptr_t)V_lds + v_rd_base(lane);
  struct { typename St::T vs0, vs1, ks0, ks1; } sr_[SDEPTH];
#define SLOAD(i, k0) do { sr_[i].vs0 = St::ld8(&Vh[(long)((k0) + sr) * LDK + sc]); sr_[i].vs1 = St::ld8(&Vh[(long)((k0) + 32 + sr) * LDK + sc]); \
    sr_[i].ks0 = St::ld8(&Kh[(long)((k0) + sr) * LDK + sc]); sr_[i].ks1 = St::ld8(&Kh[(long)((k0) + 32 + sr) * LDK + sc]); } while (0)
#define SWRITE(b, i) do { *(bf16x8*)((char*)V_lds + (b) * SHM_V + vst0) = St::tobf(sr_[i].vs0);          \
    *(bf16x8*)((char*)V_lds + (b) * SHM_V + vst1) = St::tobf(sr_[i].vs1); int kc = sc * 2;               \
    *(bf16x8*)((char*)K_lds + (b) * SHM_K + KSWZ(sr, kc)) = St::tobf(sr_[i].ks0);                       \
    *(bf16x8*)((char*)K_lds + (b) * SHM_K + KSWZ(32 + sr, kc)) = St::tobf(sr_[i].ks1); } while (0)
#define SWAIT() do { if constexpr (SDEPTH == 2) asm volatile("s_waitcnt vmcnt(4)" ::: "memory"); else asm volatile("s_waitcnt vmcnt(0)" ::: "memory"); } while (0)
#define RESC(a) do { if (__any((a) < 1.f)) { if (hi == 0) al_l[r32] = (a); asm volatile("s_waitcnt lgkmcnt(0)" ::: "memory"); \
    for (int d = 0; d < 4; ++d) for (int r = 0; r < 16; ++r) o[d][r] *= al_l[crow(r, hi)]; } } while (0)
  f32x16 pA0, pA1, pB0, pB1; float mnA, mnB, alA, alB; bf16x8 pa0, pa1, pa2, pa3; const int NT = seq / KVBLK;
  constexpr int SE = 0, SO = SDEPTH - 1;
  SLOAD(SE, 0); asm volatile("s_waitcnt vmcnt(0)" ::: "memory"); SWRITE(0, SE); __syncthreads();
  qkt(pA0, pA1, K_lds, qr, r32, hi); partialSM(pA0, pA1, m_reg, mnA, alA);
  SLOAD(SO, KVBLK); if constexpr (SDEPTH == 2) { if (2 < NT) SLOAD(SE, 2 * KVBLK); }
  SWAIT(); SWRITE(1, SO); __syncthreads();
  for (int j = 1; j + 1 < NT; j += 2) {
    SBAR(); qkt(pB0, pB1, (bf16*)((char*)K_lds + SHM_K), qr, r32, hi);
    finishSM(pA0, pA1, alA, l_reg, pa0, pa1, pa2, pa3); SBAR();
    SLOAD(SO, (j + SDEPTH) * KVBLK); SBAR();
    pv_d0(o, vb0, pa0, pa1, pa2, pa3); partialSM(pB0, pB1, m_reg, mnB, alB);
    __syncthreads(); SWAIT(); SWRITE(0, SE);
    RESC(alB); __syncthreads();
    SBAR(); qkt(pA0, pA1, K_lds, qr, r32, hi);
    finishSM(pB0, pB1, alB, l_reg, pa0, pa1, pa2, pa3); SBAR();
    if (SDEPTH == 1 || j + 3 < NT) SLOAD(SE, (j + 1 + SDEPTH) * KVBLK); SBAR();
    pv_d0(o, vb0 + (int)SHM_V, pa0, pa1, pa2, pa3); partialSM(pA0, pA1, m_reg, mnA, alA);
    __syncthreads(); SWAIT(); SWRITE(1, SO);
    RESC(alA); __syncthreads();
  }
  SBAR(); qkt(pB0, pB1, (bf16*)((char*)K_lds + SHM_K), qr, r32, hi);
  finishSM(pA0, pA1, alA, l_reg, pa0, pa1, pa2, pa3); SBAR();
  pv_d0(o, vb0, pa0, pa1, pa2, pa3); partialSM(pB0, pB1, m_reg, mnB, alB);
  __syncthreads(); RESC(alB);
  finishSM(pB0, pB1, alB, l_reg, pa0, pa1, pa2, pa3); SBAR();
  pv_d0(o, vb0 + (int)SHM_V, pa0, pa1, pa2, pa3);
  if (hi == 0) li_l[r32] = l_reg; asm volatile("s_waitcnt lgkmcnt(0)" ::: "memory");
  float rli[16];
#pragma unroll
  for (int r = 0; r < 16; ++r) rli[r] = __builtin_amdgcn_rcpf(li_l[crow(r, hi)]);
  bf16* Ow = Ob + (long)(wid * QBLK) * LDO;
#pragma unroll
  for (int r = 0; r < 16; ++r) { int orow = crow(r, hi);
    for (int d0 = 0; d0 < 4; ++d0) Ow[(long)orow * LDO + d0 * 32 + r32] = __float2bfloat16(o[d0][r] * rli[r]); }
#undef SLOAD
#undef SWRITE
#undef SWAIT
#undef RESC
}

constexpr int PC_K = 0, PC_V = 32768, PC_XP = 98304, PC_XAL = 131072, PC_LI = 133120, PC_LDS_BYTES = 133632;
struct PCStage { bf16x8 k0, k1, v00, v01, v10, v11; };
__device__ __forceinline__ void pc_sload(PCStage& st, const bf16* __restrict__ Kh, const bf16* __restrict__ Vh, bool doK, int kK, bool doV, int kV, int sr, int sc) {
  if (doK) { st.k0  = *reinterpret_cast<const bf16x8*>(Kh + (long)(kK + sr) * LDK + sc);       st.k1  = *reinterpret_cast<const bf16x8*>(Kh + (long)(kK + 32 + sr) * LDK + sc); }
  if (doV) { st.v00 = *reinterpret_cast<const bf16x8*>(Vh + (long)(kV + sr) * LDK + sc);       st.v01 = *reinterpret_cast<const bf16x8*>(Vh + (long)(kV + 32 + sr) * LDK + sc);
             st.v10 = *reinterpret_cast<const bf16x8*>(Vh + (long)(kV + sr) * LDK + 128 + sc); st.v11 = *reinterpret_cast<const bf16x8*>(Vh + (long)(kV + 32 + sr) * LDK + 128 + sc); }
}
__device__ __forceinline__ void pc_swrite(const PCStage& st, char* lds, bool doK, int kbuf, bool doV, int vbuf, int sr, int sc, int vst0, int vst1) {
  if (doK) { char* K_ = lds + PC_K + kbuf * 16384; const int kc = sc * 2;
    *reinterpret_cast<bf16x8*>(K_ + KSWZ(sr, kc)) = st.k0; *reinterpret_cast<bf16x8*>(K_ + KSWZ(32 + sr, kc)) = st.k1; }
  if (doV) { char* V0 = lds + PC_V + (vbuf * 2) * 16384; char* V1 = V0 + 16384;
    *reinterpret_cast<bf16x8*>(V0 + vst0) = st.v00; *reinterpret_cast<bf16x8*>(V0 + vst1) = st.v01;
    *reinterpret_cast<bf16x8*>(V1 + vst0) = st.v10; *reinterpret_cast<bf16x8*>(V1 + vst1) = st.v11; }
}
__device__ __forceinline__ void pc_consume(f32x16 (&o)[8], char* lds, int vbase, int pbuf, int pw, int lane, int hi) {
  const float* xa = reinterpret_cast<const float*>(lds + PC_XAL + (pbuf * 4 + pw) * 256);
  if (__builtin_amdgcn_readfirstlane(__float_as_int(xa[32])) != 0) {
#pragma unroll
    for (int r = 0; r < 16; ++r) { const float a = xa[crow(r, hi)];
#pragma unroll
      for (int d = 0; d < 8; ++d) o[d][r] *= a; }
  }
  const u32x4* xp = reinterpret_cast<const u32x4*>(lds + PC_XP + (pbuf * 4 + pw) * 4096) + lane;
  const u32x4 w0 = xp[0], w1 = xp[64], w2 = xp[128], w3 = xp[192];
  const bf16x8 pa0 = __builtin_bit_cast(bf16x8, w0), pa1 = __builtin_bit_cast(bf16x8, w1), pa2 = __builtin_bit_cast(bf16x8, w2), pa3 = __builtin_bit_cast(bf16x8, w3);
  const int vb0 = vbase + (pbuf * 2) * 16384, vb1 = vb0 + 16384;
  pv_one<0>(o[0], vb0, pa0, pa1, pa2, pa3); pv_one<1>(o[1], vb0, pa0, pa1, pa2, pa3); pv_one<2>(o[2], vb0, pa0, pa1, pa2, pa3); pv_one<3>(o[3], vb0, pa0, pa1, pa2, pa3);
  pv_one<0>(o[4], vb1, pa0, pa1, pa2, pa3); pv_one<1>(o[5], vb1, pa0, pa1, pa2, pa3); pv_one<2>(o[6], vb1, pa0, pa1, pa2, pa3); pv_one<3>(o[7], vb1, pa0, pa1, pa2, pa3);
}
template <int D0> __device__ __forceinline__ void pv_two(f32x16& oa, f32x16& ob, int vb, bf16x8 a0, bf16x8 a1, bf16x8 a2, bf16x8 a3, bf16x8 b0, bf16x8 b1, bf16x8 b2, bf16x8 b3) {
  const s16x4 l0 = tr_read<v_rd_off(D0, 0, 0)>(vb), h0 = tr_read<v_rd_off(D0, 0, 1)>(vb), l1 = tr_read<v_rd_off(D0, 1, 0)>(vb), h1 = tr_read<v_rd_off(D0, 1, 1)>(vb);
  const s16x4 l2 = tr_read<v_rd_off(D0, 2, 0)>(vb), h2 = tr_read<v_rd_off(D0, 2, 1)>(vb), l3 = tr_read<v_rd_off(D0, 3, 0)>(vb), h3 = tr_read<v_rd_off(D0, 3, 1)>(vb);
  asm volatile("s_waitcnt lgkmcnt(0)" ::: "memory"); SBAR();
#define PK(L, H) (bf16x8){L[0], L[1], L[2], L[3], H[0], H[1], H[2], H[3]}
  oa = __builtin_amdgcn_mfma_f32_32x32x16_bf16(a0, PK(l0, h0), oa, 0, 0, 0); ob = __builtin_amdgcn_mfma_f32_32x32x16_bf16(b0, PK(l0, h0), ob, 0, 0, 0);
  oa = __builtin_amdgcn_mfma_f32_32x32x16_bf16(a1, PK(l1, h1), oa, 0, 0, 0); ob = __builtin_amdgcn_mfma_f32_32x32x16_bf16(b1, PK(l1, h1), ob, 0, 0, 0);
  oa = __builtin_amdgcn_mfma_f32_32x32x16_bf16(a2, PK(l2, h2), oa, 0, 0, 0); ob = __builtin_amdgcn_mfma_f32_32x32x16_bf16(b2, PK(l2, h2), ob, 0, 0, 0);
  oa = __builtin_amdgcn_mfma_f32_32x32x16_bf16(a3, PK(l3, h3), oa, 0, 0, 0); ob = __builtin_amdgcn_mfma_f32_32x32x16_bf16(b3, PK(l3, h3), ob, 0, 0, 0);
#undef PK
}
__device__ __forceinline__ void pc_consume2(f32x16 (&o)[8], char* lds, int vbh  , int pbuf, int rg2, int lane, int hi) {
  const int sa = pbuf * 4 + 2 * rg2;
  const float* xaA = reinterpret_cast<const float*>(lds + PC_XAL + sa * 256); const float* xaB = xaA + 64;
  if (__builtin_amdgcn_readfirstlane(__float_as_int(xaA[32])) != 0) {
#pragma unroll
    for (int r = 0; r < 16; ++r) { const float a = xaA[crow(r, hi)];
#pragma unroll
      for (int d = 0; d < 4; ++d) o[d][r] *= a; } }
  if (__builtin_amdgcn_readfirstlane(__float_as_int(xaB[32])) != 0) {
#pragma unroll
    for (int r = 0; r < 16; ++r) { const float a = xaB[crow(r, hi)];
#pragma unroll
      for (int d = 0; d < 4; ++d) o[4 + d][r] *= a; } }
  const u32x4* xpA = reinterpret_cast<const u32x4*>(lds + PC_XP + sa * 4096) + lane; const u32x4* xpB = xpA + 256;
  const u32x4 wa0 = xpA[0], wa1 = xpA[64], wa2 = xpA[128], wa3 = xpA[192], wb0 = xpB[0], wb1 = xpB[64], wb2 = xpB[128], wb3 = xpB[192];
  const bf16x8 a0 = __builtin_bit_cast(bf16x8, wa0), a1 = __builtin_bit_cast(bf16x8, wa1), a2 = __builtin_bit_cast(bf16x8, wa2), a3 = __builtin_bit_cast(bf16x8, wa3);
  const bf16x8 b0 = __builtin_bit_cast(bf16x8, wb0), b1 = __builtin_bit_cast(bf16x8, wb1), b2 = __builtin_bit_cast(bf16x8, wb2), b3 = __builtin_bit_cast(bf16x8, wb3);
  const int vb = vbh + (pbuf * 2) * 16384;
  pv_two<0>(o[0], o[4], vb, a0, a1, a2, a3, b0, b1, b2, b3); pv_two<1>(o[1], o[5], vb, a0, a1, a2, a3, b0, b1, b2, b3);
  pv_two<2>(o[2], o[6], vb, a0, a1, a2, a3, b0, b1, b2, b3); pv_two<3>(o[3], o[7], vb, a0, a1, a2, a3, b0, b1, b2, b3);
}
__device__ __forceinline__ void attn_pc_unit(const bf16* __restrict__ Qb, const bf16* __restrict__ Kh, const bf16* __restrict__ Vh, bf16* __restrict__ Ob, char* lds, int rot) {
#define PC_KT(X) ((((X) + rot) & (NT - 1)) * KVBLK)
  int tid_ = threadIdx.x; asm volatile("" : "+v"(tid_));
  const int tid = tid_, lane = tid & 63, r32 = lane & 31, hi = lane >> 5;
  const int wid = __builtin_amdgcn_readfirstlane(tid >> 6), pw = wid & 3;
  const int sr = tid >> 4, sc = (tid & 15) * 8, vst0 = v_st(sr, sc), vst1 = v_st(32 + sr, sc);
  constexpr int NT = 4096 / KVBLK;
  PCStage st;
  pc_sload(st, Kh, Vh, true, PC_KT(0), false, 0, sr, sc); pc_swrite(st, lds, true, 0, false, 0, sr, sc, vst0, vst1);
  pc_sload(st, Kh, Vh, true, PC_KT(1), true, PC_KT(0), sr, sc);
  if (wid < 4) {
    bf16x8 qr[8]; const bf16* Qw = Qb + (long)(pw * QBLK + r32) * LDQ + hi * 8;
#pragma unroll
    for (int d0 = 0; d0 < 8; ++d0) qr[d0] = *reinterpret_cast<const bf16x8*>(Qw + d0 * 16);
    float m_reg = -1e30f, l_reg = 0.f;
    __syncthreads();
    for (int j = 0; j < NT; ++j) {
      const int buf = j & 1;
      pc_swrite(st, lds, j + 1 < NT, buf ^ 1, true, buf, sr, sc, vst0, vst1);
      pc_sload(st, Kh, Vh, j + 2 < NT, PC_KT(j + 2), j + 1 < NT, PC_KT(j + 1), sr, sc);
      f32x16 p0, p1; float mn, alpha; bf16x8 pa0, pa1, pa2, pa3;
      SBAR(); qkt(p0, p1, reinterpret_cast<const bf16*>(lds + PC_K + buf * 16384), qr, r32, hi);
      partialSM(p0, p1, m_reg, mn, alpha); finishSM(p0, p1, alpha, l_reg, pa0, pa1, pa2, pa3);
      { u32x4* xp = reinterpret_cast<u32x4*>(lds + PC_XP + (buf * 4 + pw) * 4096) + lane;
        xp[0] = __builtin_bit_cast(u32x4, pa0); xp[64] = __builtin_bit_cast(u32x4, pa1); xp[128] = __builtin_bit_cast(u32x4, pa2); xp[192] = __builtin_bit_cast(u32x4, pa3);
        float* xa = reinterpret_cast<float*>(lds + PC_XAL + (buf * 4 + pw) * 256);
        const float fl = __any(alpha < 1.f) ? 1.f : 0.f;
        if (hi == 0) xa[r32] = alpha;
        if (lane == 0) xa[32] = fl; }
      __syncthreads();
    }
    if (hi == 0) reinterpret_cast<float*>(lds + PC_LI)[pw * 32 + r32] = l_reg;
    __syncthreads();
    __syncthreads();
  } else {
    f32x16 o[8] = {};
    const int rg2 = pw & 1, vh = pw >> 1;
    const int vbh = (int)(uintptr_t)(lds + PC_V) + vh * 16384 + v_rd_base(lane);
    __syncthreads();
    for (int j = 0; j < NT; ++j) {
      const int buf = j & 1;
      pc_swrite(st, lds, j + 1 < NT, buf ^ 1, true, buf, sr, sc, vst0, vst1);
      pc_sload(st, Kh, Vh, j + 2 < NT, PC_KT(j + 2), j + 1 < NT, PC_KT(j + 1), sr, sc);
      if (j > 0) pc_consume2(o, lds, vbh, buf ^ 1, rg2, lane, hi);
      __syncthreads();
    }
    pc_consume2(o, lds, vbh, (NT - 1) & 1, rg2, lane, hi);
    __syncthreads();
    const float* li = reinterpret_cast<const float*>(lds + PC_LI) + (2 * rg2) * 32;
    float rla[16], rlb[16];
#pragma unroll
    for (int r = 0; r < 16; ++r) { rla[r] = __builtin_amdgcn_rcpf(li[crow(r, hi)]); rlb[r] = __builtin_amdgcn_rcpf(li[32 + crow(r, hi)]); }
    bf16* Ow = Ob + (long)(2 * rg2 * QBLK) * LDO + vh * 128;
#pragma unroll
    for (int r = 0; r < 16; ++r) { const int orow = crow(r, hi);
#pragma unroll
      for (int d0 = 0; d0 < 4; ++d0) { Ow[(long)orow * LDO + d0 * 32 + r32] = __float2bfloat16(o[d0][r] * rla[r]); Ow[(long)(QBLK + orow) * LDO + d0 * 32 + r32] = __float2bfloat16(o[4 + d0][r] * rlb[r]); } }
    __syncthreads();
  }
}
#undef PC_KT
#undef SBAR
#undef KSWZ
}

#ifndef MK_PER_PHASE
#define MK_PER_PHASE 0
#endif
#define GAS __attribute__((address_space(1)))
#define LAS __attribute__((address_space(3)))
typedef unsigned short bf16;
typedef unsigned v4u __attribute__((ext_vector_type(4)));
typedef unsigned v2u __attribute__((ext_vector_type(2)));
typedef float f32x4 __attribute__((ext_vector_type(4)));
#define LDS_WAIT() asm volatile("s_waitcnt lgkmcnt(0)" ::: "memory")

constexpr int NWAVES = 8, NTHREADS = 512;
constexpr int BATCH = 4, SEQ = 4096, DM = 2048, M = BATCH * SEQ;
constexpr int NH = 6, QKW = 1536, VW = 1536, FW = 512, INW = 9216, DFF = 5632;
constexpr float RMS_EPS = 1e-5f, LAMBDA_INIT = 0.2f;
constexpr int NPHASES = 10;
constexpr size_t MiB = 1u << 20;
constexpr size_t WS_INV0 = 0, WS_SS1 = 64 * 1024, WS_SS2 = 128 * 1024, WS_BAR = 192 * 1024  , WS_BAR_BYTES = 16384, WS_ROPE = 256 * 1024;
constexpr size_t WS_WIN = 1 * MiB, WS_WA = 37 * MiB, WS_WCS = 43 * MiB, WS_WOUT = 47 * MiB, WS_WGU = 55 * MiB, WS_WDN = 99 * MiB;
constexpr size_t WS_ADFT = 121 * MiB;
constexpr size_t WS_Q = 185 * MiB, WS_K = 233 * MiB, WS_V = 281 * MiB, WS_FT = 329 * MiB, WS_GA = 345 * MiB, WS_GF = 409 * MiB, WS_F = 473 * MiB, WS_END = 489 * MiB;
constexpr size_t WS_O = WS_Q;
constexpr size_t WS_G = 297 * MiB;
constexpr size_t WS_P1 = WS_K;
constexpr size_t WS_MG = WS_ADFT;
constexpr size_t WS_X1G = WS_GF;
constexpr size_t WS_U = WS_Q;
static_assert(WS_U + (size_t)M * DFF * 2 <= WS_GF, "u must not reach x1g");
constexpr size_t DO_XG = 0, DO_OPC = 0, DO_G = 96 * MiB;
constexpr int LDS_BYTES = 147456;

struct Args { const float* in[16]; float* out; unsigned char* ws; int ph_lo, ph_hi, rmask, pad; };

__device__ __forceinline__ unsigned f2bf(float f) { unsigned u = __builtin_bit_cast(unsigned, f); return (u + 0x7fffu + ((u >> 16) & 1u)) >> 16; }
__device__ __forceinline__ unsigned pk2(float lo, float hi) { return f2bf(lo) | (f2bf(hi) << 16); }
__device__ __forceinline__ float wave_sum(float v) {
#pragma unroll
    for (int o = 1; o < 64; o <<= 1) v += __shfl_xor(v, o);
    return v;
}
static __device__ const double INVF[16] = {1.0, 0.44036660267178046, 0.19392274474868576, 0.08539710028576561, 0.03760603093086393, 0.016560440080994446, 0.007292664737217109,
    0.003211445994752591, 0.001414213562373095, 0.000622772421914596, 0.0002742481756762073, 0.00012076973741146504, 5.318295896944988e-05, 2.341999896140934e-05,
    1.031338537721246e-05, 4.5416704806078695e-06};

__device__ __forceinline__ void tr_item(const float* cp, int dl4, size_t ld, int K, bf16* WTblk  , LAS float* scr, int lane) {
    f32x4 v[8];
#pragma unroll
    for (int i = 0; i < 8; ++i) v[i] = *(const f32x4*)(cp + (size_t)(8 * i) * ld);
    LAS float* d = scr + (lane >> 3) * 33 + dl4;
#pragma unroll
    for (int i = 0; i < 8; ++i) { d[(8 * i) * 33 + 0] = v[i].x; d[(8 * i) * 33 + 1] = v[i].y; d[(8 * i) * 33 + 2] = v[i].z; d[(8 * i) * 33 + 3] = v[i].w; }
    LDS_WAIT(); asm volatile("" ::: "memory");
    const int c = lane & 7;
#pragma unroll
    for (int j = 0; j < 4; ++j) { const int n = (lane >> 3) + 8 * j; const LAS float* s = scr + (8 * c) * 33 + n;
        v4u o; o.x = pk2(s[0 * 33], s[1 * 33]); o.y = pk2(s[2 * 33], s[3 * 33]); o.z = pk2(s[4 * 33], s[5 * 33]); o.w = pk2(s[6 * 33], s[7 * 33]);
        *(v4u*)(WTblk + (size_t)n * K + 8 * c) = o; }
    LDS_WAIT(); asm volatile("" ::: "memory");
}

#define XB_TMO      128
#define XB_XCNT(j)  (256  + 64 * (j))
#define XB_XSUB(j)  (1280 + 64 * (j))
#define XB_XGEN(j)  (2304 + 64 * (j))
#define XB_TOP      3328
#define XB_TOPGEN   3392
#define XCD_BAR_WORDS 3456
#define XB_SPIN_CAP (1u << 18)

__device__ __forceinline__ unsigned xb_ld(unsigned* p)              { return __hip_atomic_load(p, __ATOMIC_RELAXED, __HIP_MEMORY_SCOPE_AGENT); }
__device__ __forceinline__ unsigned xb_add(unsigned* p, unsigned v) { return __hip_atomic_fetch_add(p, v, __ATOMIC_RELAXED, __HIP_MEMORY_SCOPE_AGENT); }
__device__ __forceinline__ unsigned xb_xcc_id() { return (unsigned)__builtin_amdgcn_s_getreg((3 << 11) | 20) & 0xFu; }
#define XB_SPIN(cond, bar) do { unsigned _sp = 0; while (cond) { __builtin_amdgcn_s_sleep(1); \
    if ((++_sp & 255u) == 0u) { if (xb_ld(&(bar)[XB_TMO])) break; if (_sp > XB_SPIN_CAP) { atomicAdd(&(bar)[XB_TMO], 1u); break; } } } } while (0)

struct XcdBarrier {
    unsigned* bar; unsigned x;
    volatile LAS unsigned* st;
};

__device__ __forceinline__ XcdBarrier xcd_barrier_post(unsigned* bar, volatile LAS unsigned* st) {
    XcdBarrier b; b.bar = bar; b.x = xb_xcc_id(); b.st = st;
    if (threadIdx.x == 0) (void)xb_add(&bar[XB_XCNT(b.x)], 1u);
    return b;
}
__device__ __forceinline__ void xcd_barrier_complete(unsigned* bar, unsigned x, unsigned& nloc, unsigned& nx) {
    const unsigned G = gridDim.x * gridDim.y * gridDim.z;
    unsigned sum, cnt, mine, sp = 0u;
    for (;;) {
        sum = 0u; cnt = 0u; mine = 0u;
#pragma unroll
        for (unsigned j = 0; j < 16; ++j) { const unsigned c = xb_ld(&bar[XB_XCNT(j)]); sum += c; cnt += (c > 0u) ? 1u : 0u; mine = (j == x) ? c : mine; }
        if (sum == G) break;
        __builtin_amdgcn_s_sleep(1);
        if ((++sp & 255u) == 0u) { if (xb_ld(&bar[XB_TMO])) break; if (sp > XB_SPIN_CAP) { atomicAdd(&bar[XB_TMO], 1u); break; } }
    }
    nloc = mine > 0u ? mine : 1u; nx = cnt > 0u ? cnt : 1u;
}

__device__ __forceinline__ void xcd_barrier(const XcdBarrier& b) {
    asm volatile("s_waitcnt vmcnt(0)" ::: "memory");
    __syncthreads();
    if (threadIdx.x == 0) {
        unsigned* bar = b.bar;
        __builtin_amdgcn_s_waitcnt(0);
        unsigned nloc = b.st[0], nx = b.st[1];
        if (nloc == 0u) { xcd_barrier_complete(bar, b.x, nloc, nx); b.st[0] = nloc; b.st[1] = nx; }
        const unsigned old = xb_add(&bar[XB_XSUB(b.x)], 1u);
        const unsigned gen = old / nloc;
        if (old + 1u == (gen + 1u) * nloc) {
            __builtin_amdgcn_fence(__ATOMIC_RELEASE, "agent");
            asm volatile("s_waitcnt vmcnt(0)" ::: "memory");
            const unsigned og = xb_add(&bar[XB_TOP], 1u);
            const unsigned tg = og / nx;
            if (og + 1u == (tg + 1u) * nx) xb_add(&bar[XB_TOPGEN], 1u);
            else XB_SPIN(xb_ld(&bar[XB_TOPGEN]) == tg, bar);
            __builtin_amdgcn_fence(__ATOMIC_ACQUIRE, "agent");
            xb_add(&bar[XB_XGEN(b.x)], 1u);
            asm volatile("s_waitcnt vmcnt(0)" ::: "memory");
        } else {
            XB_SPIN(xb_ld(&bar[XB_XGEN(b.x)]) == gen, bar);
            __builtin_amdgcn_fence(__ATOMIC_ACQUIRE, "agent");
            asm volatile("s_waitcnt vmcnt(0)" ::: "memory");
        }
    }
    __syncthreads();
}

__global__ void __launch_bounds__(NTHREADS, 2) mk_fwd(Args args) {
    extern __shared__ __attribute__((aligned(16))) unsigned char lds[];
    cg::grid_group grid = cg::this_grid();
    const int tid = threadIdx.x, lane = tid & 63, wave = __builtin_amdgcn_readfirstlane(tid >> 6);
    const int G = gridDim.x, bx = blockIdx.x, vcu = (G % 8 == 0) ? (bx % 8) * (G / 8) + bx / 8 : bx;
    const int gw = vcu * NWAVES + wave, NGW = G * NWAVES;
    volatile LAS unsigned* xbst = (volatile LAS unsigned*)((LAS unsigned char*)lds + LDS_BYTES - 16);
    if (tid == 0) { xbst[0] = 0u; xbst[1] = 0u; }
    __syncthreads();
    const XcdBarrier xbar = xcd_barrier_post((unsigned*)(args.ws + WS_BAR), xbst);
    if (args.ph_hi > 1000) grid.sync();
    const long gtid = (long)bx * NTHREADS + tid, NGT = (long)G * NTHREADS;
    unsigned char* ws = args.ws; unsigned char* dout = (unsigned char*)args.out;
    const float* x = args.in[0]; const float* g_mix = args.in[1]; const float* w_in = args.in[2];
    const float* lq1 = args.in[3]; const float* lk1 = args.in[4]; const float* lq2 = args.in[5]; const float* lk2 = args.in[6];
    const float* g_subln = args.in[7]; const float* w_attn = args.in[8]; const float* w_four = args.in[9]; const float* w_out = args.in[10];
    const float* g_ffn = args.in[11]; const float* w_gate = args.in[12]; const float* w_up = args.in[13]; const float* w_down = args.in[14]; const float* g_final = args.in[15];
    float* inv0 = (float*)(ws + WS_INV0); float* ss1 = (float*)(ws + WS_SS1); float* ss2 = (float*)(ws + WS_SS2); float* rope = (float*)(ws + WS_ROPE);
    bf16* WIN = (bf16*)(ws + WS_WIN); bf16* WA = (bf16*)(ws + WS_WA); bf16* WCS = (bf16*)(ws + WS_WCS); bf16* WOUT = (bf16*)(ws + WS_WOUT); bf16* WGU = (bf16*)(ws + WS_WGU); bf16* WDN = (bf16*)(ws + WS_WDN);
    bf16* ADFT = (bf16*)(ws + WS_ADFT);
    bf16* Qb = (bf16*)(ws + WS_Q); bf16* Kb = (bf16*)(ws + WS_K); bf16* Vb = (bf16*)(ws + WS_V); bf16* FT = (bf16*)(ws + WS_FT); bf16* Fb = (bf16*)(ws + WS_F); bf16* GAb = (bf16*)(ws + WS_GA); bf16* GFb = (bf16*)(ws + WS_GF);
    bf16* Ob = (bf16*)(ws + WS_O); bf16* P1 = (bf16*)(ws + WS_P1); bf16* MG = (bf16*)(ws + WS_MG); bf16* X1G = (bf16*)(ws + WS_X1G); bf16* Ub = (bf16*)(ws + WS_U);
    bf16* XG = (bf16*)(dout + DO_XG); bf16* OPC = (bf16*)(dout + DO_OPC);
#if defined(MK_PROBE) && MK_PROBE == 5
    bf16* Gb = (bf16*)(ws + WS_V);
#else
    bf16* Gb = (bf16*)(ws + WS_G);
#endif
    LAS unsigned char* glds = (LAS unsigned char*)lds;

    const int lo = args.ph_lo, hi = args.ph_hi, rmask = args.rmask;
#ifndef MK_PHASE_MASK
#define MK_PHASE_MASK 0x3ff
#endif
#define IN(k) ((((MK_PHASE_MASK) >> (k)) & 1) && ((rmask >> (k)) & 1) && lo <= (k) && (k) < hi)
#define SEAM(k) do { if (IN(k) && IN((k) + 1)) xcd_barrier(xbar); } while (0)
#ifndef MK_REPEAT
#define MK_REPEAT -1
#endif
#define REP(k) for (int rep_ = 0; rep_ < ((k) == MK_REPEAT ? 2 : 1); ++rep_)

#if defined(MK_SELFPOISON)
    { const v4u pz = {0xAAAAAAAAu, 0xAAAAAAAAu, 0xAAAAAAAAu, 0xAAAAAAAAu};
      v4u* zp = (v4u*)ws; const size_t n16 = (size_t)WS_END / 16; for (size_t i = (size_t)gtid; i < n16; i += (size_t)NGT) zp[i] = pz;
      v4u* op = (v4u*)dout; const size_t o16 = (size_t)M * DM * 4 / 16; for (size_t i = (size_t)gtid; i < o16; i += (size_t)NGT) op[i] = pz;
      grid.sync(); }
#endif
    REP(0) if (IN(0)) {
        for (long i = gtid; i < 2 * M; i += NGT) ss1[i] = 0.f;
#if defined(MK_NANFILL)
        { v4u* zp = (v4u*)(ws + WS_Q); const size_t n16 = (size_t)(WS_END - WS_Q) / 16; const v4u nanv = {0x7fc07fc0u, 0x7fc07fc0u, 0x7fc07fc0u, 0x7fc07fc0u};
          for (size_t i = (size_t)gtid; i < n16; i += (size_t)NGT) zp[i] = nanv; }
#endif
        for (int m = gw; m < M; m += NGW) {
            const GAS f32x4* xr = (const GAS f32x4*)(x + (size_t)m * DM) + lane; const f32x4* g4 = (const f32x4*)g_mix + lane;
            f32x4 v[8]; float s = 0.f;
#pragma unroll
            for (int j = 0; j < 8; ++j) { v[j] = xr[64 * j]; s += (v[j].x * v[j].x + v[j].y * v[j].y) + (v[j].z * v[j].z + v[j].w * v[j].w); }
            s = wave_sum(s);
            if (lane == 0) inv0[m] = 1.0f / sqrtf(s * (1.0f / DM) + RMS_EPS);
            v2u* o8 = (v2u*)(XG + (size_t)m * DM) + lane;
#pragma unroll
            for (int j = 0; j < 8; ++j) { const f32x4 g = g4[64 * j]; v2u w; w.x = pk2(v[j].x * g.x, v[j].y * g.y); w.y = pk2(v[j].z * g.z, v[j].w * g.w); o8[64 * j] = w; }
        }
        {
            LAS float* scr = (LAS float*)((LAS unsigned char*)lds + wave * 16384);
            constexpr int I_IN = (DM / 64) * (INW / 32), I_A = (VW / 64) * (DM / 32), I_O = (DM / 64) * (DM / 32), I_GU = (DM / 64) * (2 * DFF / 32), I_DN = (DFF / 64) * (DM / 32);
            constexpr int NITEMS = I_IN + I_A + I_O + I_GU + I_DN;
            const int q = lane & 7, q4 = q * 4, kr = lane >> 3;
            for (int it = gw; it < NITEMS; it += NGW) {
                int r = it;
                if (r < I_IN) { const int nblk = INW / 32, kb = r / nblk, nb = r % nblk; tr_item(w_in + (size_t)(64 * kb + kr) * INW + 32 * nb + q4, q4, INW, DM, WIN + (size_t)(32 * nb) * DM + 64 * kb, scr, lane); continue; } r -= I_IN;
                if (r < I_A) { const int nblk = DM / 32, kb = r / nblk, nb = r % nblk; tr_item(w_attn + (size_t)(64 * kb + kr) * DM + 32 * nb + q4, q4, DM, VW, WA + (size_t)(32 * nb) * VW + 64 * kb, scr, lane); continue; } r -= I_A;
                if (r < I_O) { const int nblk = DM / 32, kb = r / nblk, nb = r % nblk; tr_item(w_out + (size_t)(64 * kb + kr) * DM + 32 * nb + q4, q4, DM, DM, WOUT + (size_t)(32 * nb) * DM + 64 * kb, scr, lane); continue; } r -= I_O;
                if (r < I_GU) { const int nblk = 2 * DFF / 32, kb = r / nblk, nb = r % nblk;
                    const int nn = q >> 2, j = (q & 3) * 4, dl4 = 8 * (q & 3) + 4 * nn;
                    tr_item((nn ? w_up : w_gate) + (size_t)(64 * kb + kr) * DFF + 16 * nb + j, dl4, DFF, DM, WGU + (size_t)(32 * nb) * DM + 64 * kb, scr, lane); continue; } r -= I_GU;
                { const int nblk = DM / 32, kb = r / nblk, nb = r % nblk; tr_item(w_down + (size_t)(64 * kb + kr) * DM + 32 * nb + q4, q4, DM, DFF, WDN + (size_t)(32 * nb) * DFF + 64 * kb, scr, lane); }
            }
        }
        for (long t = gtid; t < (long)4096 * 256; t += NGT) {
            const int m = (int)(t >> 8), s0 = (int)(t & 255) * 8, part = m >> 11, k = 2 * (m & 1023) + ((m >> 10) & 1); float v[8];
#pragma unroll
            for (int e = 0; e < 8; ++e) { const float ph = (float)((k * (s0 + e)) & 4095) * (1.0f / 4096.0f); v[e] = part ? __builtin_amdgcn_sinf(ph) : __builtin_amdgcn_cosf(ph); }
            v4u o; o.x = pk2(v[0], v[1]); o.y = pk2(v[2], v[3]); o.z = pk2(v[4], v[5]); o.w = pk2(v[6], v[7]);
            *(v4u*)(ADFT + (size_t)m * 2048 + s0) = o;
        }
        for (long t = gtid; t < 4096 * 16; t += NGT) {
            const int pos = (int)(t >> 4), j = (int)(t & 15);
            double rev = (double)pos * INVF[j] * 0.15915494309189535; rev -= floor(rev);
            const float r = (float)rev; rope[2 * t] = __builtin_amdgcn_cosf(r); rope[2 * t + 1] = __builtin_amdgcn_sinf(r);
        }
    }
    SEAM(0);

    REP(1) if (IN(1)) {
        pg8::Gemm g{XG, WIN, M, INW, DM}; pg8::StaticOrder S; S.init(M, INW, G, bx);
        pg8::EpiZ E{Qb, Kb, Vb, Fb, GAb, GFb, inv0, rope};
        pg8::gemm_phase<pg8::EpiZ, pg8::StaticOrder, true, true>(glds, g, S, E);
    }
    SEAM(1);

    REP(2) if (IN(2)) {
        {
            LAS unsigned short* t16 = (LAS unsigned short*)((LAS unsigned char*)lds + wave * 16384);
            for (int t = gw; t < 2048; t += NGW) {
                const int par = t & 1, tt = t >> 1, sbp = tt >> 3, nb = tt & 7, b = sbp >> 5, s0 = (sbp & 31) * 64, r0 = b * 4096 + s0;
                const float sg = par ? -1.0f : 1.0f;
#pragma unroll
                for (int i = 0; i < 8; ++i) { const int row = (lane >> 3) + 8 * i, ch = lane & 7;
                    const v4u lo4 = *(const v4u*)(Fb + (size_t)(r0 + row) * 512 + nb * 64 + ch * 8), hi4 = *(const v4u*)(Fb + (size_t)(r0 + 2048 + row) * 512 + nb * 64 + ch * 8);
                    v4u v;
#define ED(C) v.C = pk2(pg8::bflo(lo4.C) + sg * pg8::bflo(hi4.C), pg8::bfhi(lo4.C) + sg * pg8::bfhi(hi4.C))
                    ED(x); ED(y); ED(z); ED(w);
#undef ED
                    LAS unsigned short* d = t16 + (ch * 8) * 66 + row;
                    d[0 * 66] = (unsigned short)(v.x & 0xffffu); d[1 * 66] = (unsigned short)(v.x >> 16); d[2 * 66] = (unsigned short)(v.y & 0xffffu); d[3 * 66] = (unsigned short)(v.y >> 16);
                    d[4 * 66] = (unsigned short)(v.z & 0xffffu); d[5 * 66] = (unsigned short)(v.z >> 16); d[6 * 66] = (unsigned short)(v.w & 0xffffu); d[7 * 66] = (unsigned short)(v.w >> 16); }
                LDS_WAIT(); asm volatile("" ::: "memory");
                const LAS unsigned* rp = (const LAS unsigned*)(t16 + lane * 66);
                bf16* orow = FT + ((size_t)(par * 2048 + b * 512 + nb * 64 + lane)) * 2048 + s0;
#pragma unroll
                for (int j = 0; j < 8; ++j) { v4u o; o.x = rp[4 * j]; o.y = rp[4 * j + 1]; o.z = rp[4 * j + 2]; o.w = rp[4 * j + 3]; *(v4u*)(orow + 8 * j) = o; }
                LDS_WAIT(); asm volatile("" ::: "memory");
            }
            __syncthreads();
        }
        for (int i = 0;; ++i) {
            const int u = i * G + vcu; if (u >= 1536) break;
            const int qb = u & 31, grp = u >> 5, c = grp & 1, h = (grp >> 1) % NH, b = grp / (2 * NH);
            const att::bf16* Qp = (const att::bf16*)Qb + ((size_t)b * SEQ + qb * 128) * QKW + (h * 2 + c) * 128;
            const att::bf16* Kp = (const att::bf16*)Kb + ((size_t)b * SEQ) * QKW + (h * 2 + c) * 128;
            const att::bf16* Vp = (const att::bf16*)Vb + ((size_t)b * SEQ) * VW + h * 256;
            att::bf16* Op = (att::bf16*)OPC + ((size_t)b * SEQ + qb * 128) * 3072 + (h * 2 + c) * 256;
            att::attn_pc_unit(Qp, Kp, Vp, Op, (char*)lds, (2 * qb) & 63);
        }
    }
    SEAM(2);

    REP(3) if (IN(3)) {
        const int Gd = G / 2;
        constexpr int R1 = 13312;
        int c_start, c_end, c_stride;
        if (bx < Gd) {
            pg8::Gemm g{ADFT, FT, 4096, 4096, 2048}; pg8::DftOrder S; S.S0.init(4096, 2048, Gd, bx);
            pg8::EpiDft E{Gb};
            pg8::gemm_phase<pg8::EpiDft, pg8::DftOrder, true, true>(glds, g, S, E);
            c_start = R1 + bx * NWAVES + wave; c_end = M; c_stride = Gd * NWAVES;
        } else {
            const int gw2 = (bx - Gd) * NWAVES + wave, NGW2 = (G - Gd) * NWAVES;
            for (int n = gw2; n < 2048; n += NGW2) {
                const bf16* fr_ = FT + (size_t)n * 2048; float a = 0.f;
#pragma unroll
                for (int j = 0; j < 4; ++j) { const v4u w = *((const v4u*)(fr_ + j * 512) + lane);
                    a += (pg8::bflo(w.x) - pg8::bfhi(w.x)) + (pg8::bflo(w.y) - pg8::bfhi(w.y)) + (pg8::bflo(w.z) - pg8::bfhi(w.z)) + (pg8::bflo(w.w) - pg8::bfhi(w.w)); }
                a = wave_sum(a);
                if (lane == 0) { bf16* gp = Gb + ((size_t)(n >> 9) * 4096 + 2048) * 1024 + (n & 511); gp[0] = (bf16)f2bf(a); gp[512] = 0; }
            }
            for (int t = gw2; t < 1024; t += NGW2) {
                const int nchunk = t & 7, dblk = (t >> 3) & 15, g = (t >> 7) & 3, part = t >> 9, n = nchunk * 256 + lane * 4;
                f32x4 a[8];
    #pragma unroll
                for (int dd = 0; dd < 8; ++dd) a[dd] = (f32x4){0.f, 0.f, 0.f, 0.f};
                const float* wp = w_four + (size_t)(g * 128) * DM + n;
    #pragma unroll 2
                for (int c = 0; c < 128; ++c) { const f32x4 w = *(const f32x4*)(wp + (size_t)c * DM);
    #pragma unroll
                    for (int dd = 0; dd < 8; ++dd) { const float ph = (float)(((dblk * 8 + dd) * c) & 127) * (1.0f / 128.0f);
                        const float tv = part ? __builtin_amdgcn_sinf(ph) : __builtin_amdgcn_cosf(ph); a[dd] += w * tv; } }
                const float sc = (part ? -1.0f : 1.0f) * 0.0013810679320049755f;
    #pragma unroll
                for (int q = 0; q < 4; ++q) { v4u o; o.x = pk2(a[0][q] * sc, a[1][q] * sc); o.y = pk2(a[2][q] * sc, a[3][q] * sc); o.z = pk2(a[4][q] * sc, a[5][q] * sc); o.w = pk2(a[6][q] * sc, a[7][q] * sc);
                    *(v4u*)(WCS + (size_t)(n + q) * 1024 + part * 512 + g * 128 + dblk * 8) = o; }
            }
            c_start = gw2; c_end = R1; c_stride = NGW2;
        }
        float lam;
        { const float a1 = lq1[lane] * lk1[lane] + lq1[lane + 64] * lk1[lane + 64], a2 = lq2[lane] * lk2[lane] + lq2[lane + 64] * lk2[lane + 64];
          lam = expf(wave_sum(a1)) - expf(wave_sum(a2)) + LAMBDA_INIT; }
        const f32x4 gs = *((const f32x4*)g_subln + lane);
        for (int row = c_start; row < c_end; row += c_stride) {
            v2u a[NH], b2[NH];
#pragma unroll
            for (int h = 0; h < NH; ++h) { a[h] = *((const v2u*)(OPC + (size_t)row * 3072 + (2 * h) * 256) + lane); b2[h] = *((const v2u*)(OPC + (size_t)row * 3072 + (2 * h + 1) * 256) + lane); }
#pragma unroll
            for (int h = 0; h < NH; ++h) {
                f32x4 d; d.x = pg8::bflo(a[h].x) - lam * pg8::bflo(b2[h].x); d.y = pg8::bfhi(a[h].x) - lam * pg8::bfhi(b2[h].x); d.z = pg8::bflo(a[h].y) - lam * pg8::bflo(b2[h].y); d.w = pg8::bfhi(a[h].y) - lam * pg8::bfhi(b2[h].y);
                const float ss = wave_sum((d.x * d.x + d.y * d.y) + (d.z * d.z + d.w * d.w));
                const float sc = (1.0f - LAMBDA_INIT) / sqrtf(ss * (1.0f / 256.0f) + RMS_EPS);
                v2u w; w.x = pk2(d.x * sc * gs.x, d.y * sc * gs.y); w.y = pk2(d.z * sc * gs.z, d.w * sc * gs.w);
                *((v2u*)(Ob + (size_t)row * VW + h * 256) + lane) = w;
            }
        }
    }
    SEAM(3);

    REP(4) if (IN(4)) {
        pg8::Gemm g{Ob, WA, M, DM, VW}; pg8::StaticOrder S; S.init(M, DM, G, bx);
        pg8::EpiGateA E{GAb, P1};
        pg8::gemm_phase<pg8::EpiGateA, pg8::StaticOrder, true, true>(glds, g, S, E);
    }
    REP(5) if (IN(5)) {
        pg8::Gemm g{Gb, WCS, M, DM, 1024}; pg8::StaticOrder S; S.init(M, DM, G, bx);
        pg8::EpiGateF E{GFb, P1, MG};
        pg8::gemm_phase<pg8::EpiGateF, pg8::StaticOrder, true, true>(glds, g, S, E);
    }
    SEAM(5);

    REP(6) if (IN(6)) {
        pg8::Gemm g{MG, WOUT, M, DM, DM}; pg8::StaticOrder S; S.init(M, DM, G, bx);
        pg8::EpiRes<true> E{x, args.out, X1G, g_ffn, ss1};
        pg8::gemm_phase<pg8::EpiRes<true>, pg8::StaticOrder, true, true>(glds, g, S, E);
    }
    SEAM(6);

    REP(7) if (IN(7)) {
        pg8::Gemm g{X1G, WGU, M, 2 * DFF, DM}; pg8::StaticOrder S; S.init(M, 2 * DFF, G, bx);
        pg8::EpiSwiGLU E{Ub, ss1};
        pg8::gemm_phase<pg8::EpiSwiGLU, pg8::StaticOrder, true, true>(glds, g, S, E);
    }
    SEAM(7);

    REP(8) if (IN(8)) {
        pg8::Gemm g{Ub, WDN, M, DM, DFF}; pg8::StaticOrder S; S.init(M, DM, G, bx);
        pg8::EpiRes<false> E{args.out, args.out, nullptr, nullptr, ss2};
        pg8::gemm_phase<pg8::EpiRes<false>, pg8::StaticOrder, true, true>(glds, g, S, E);
    }
    SEAM(8);

    REP(9) if (IN(9)) {
        for (int m = gw; m < M; m += NGW) {
            const float rs = 1.0f / sqrtf(ss2[m] * (1.0f / DM) + RMS_EPS);
            f32x4* xr = (f32x4*)(args.out + (size_t)m * DM) + lane; const f32x4* g4 = (const f32x4*)g_final + lane;
#pragma unroll
            for (int j = 0; j < 8; ++j) xr[64 * j] = xr[64 * j] * rs * g4[64 * j];
        }
    }
#undef IN
#undef SEAM
}

#if defined(MK_PROBE)
__global__ void __launch_bounds__(256) probe_kernel(float* out, const unsigned char* ws) {
    const bf16* Ob = (const bf16*)(ws + WS_O); const bf16* MG = (const bf16*)(ws + WS_MG); const bf16* GFb = (const bf16*)(ws + WS_GF); const bf16* X1G = (const bf16*)(ws + WS_X1G);
    for (size_t i = (size_t)blockIdx.x * 256 + threadIdx.x; i < (size_t)M * DM; i += (size_t)gridDim.x * 256) {
        const size_t m = i / DM; const int c = (int)(i % DM); float v = 0.f;
#if MK_PROBE == 1
        if (c < 1536) v = __uint_as_float((unsigned)Ob[m * 1536 + c] << 16);
#elif MK_PROBE == 2
        v = __uint_as_float((unsigned)MG[m * 2048 + c] << 16);
#elif MK_PROBE == 3
        v = __uint_as_float((unsigned)GFb[m * 2048 + c] << 16);
#elif MK_PROBE == 6
        v = __uint_as_float((unsigned)((const bf16*)(ws + WS_P1))[m * 2048 + c] << 16);
#elif MK_PROBE == 5
        if (c < 1024) v = __uint_as_float((unsigned)((const bf16*)(ws + WS_V))[m * 1024 + c] << 16);
#elif MK_PROBE == 7
        { const bf16* FTp = (const bf16*)(ws + WS_FT); const size_t j = (size_t)i % ((size_t)2048 * 4096); v = __uint_as_float((unsigned)FTp[j] << 16); }
#elif MK_PROBE == 8
        if (c < 1024) v = __uint_as_float((unsigned)GFb[m * 2048 + c] << 16); else if (m < 2048) v = 1000.f * __uint_as_float((unsigned)((const bf16*)(ws + WS_WCS))[m * 1024 + (c - 1024)] << 16);
#elif MK_PROBE == 9
        v = __uint_as_float((unsigned)((const bf16*)(ws + WS_GA))[m * 2048 + c] << 16);
#elif MK_PROBE == 4
        v = __uint_as_float((unsigned)X1G[m * 2048 + c] << 16);
#endif
        out[i] = v; }
}
#endif
extern "C" void kernel_launch(void* const* d_in, const int* in_sizes, int n_in, void* d_out, int out_size, void* d_ws, size_t ws_size, hipStream_t stream) {
    static int grid = 0;
    if (grid == 0) {
        if (n_in != 16 || in_sizes[0] != M * DM || out_size != M * DM || ws_size < WS_END) {
            fprintf(stderr, "kernel_launch: unexpected shapes: n_in %d in0 %d out %d ws %zu (need >= %zu)\n", n_in, n_in > 0 ? in_sizes[0] : -1, out_size, ws_size, (size_t)WS_END); grid = -1; return; }
        int dev = 0, cus = 0, per_cu = 0;
        if (hipGetDevice(&dev) != hipSuccess || hipDeviceGetAttribute(&cus, hipDeviceAttributeMultiprocessorCount, dev) != hipSuccess) { grid = -1; return; }
        if (hipFuncSetAttribute((const void*)mk_fwd, hipFuncAttributeMaxDynamicSharedMemorySize, LDS_BYTES) != hipSuccess) { fprintf(stderr, "kernel_launch: hipFuncSetAttribute failed\n"); grid = -1; return; }
        if (hipOccupancyMaxActiveBlocksPerMultiprocessor(&per_cu, (const void*)mk_fwd, NTHREADS, LDS_BYTES) != hipSuccess || per_cu < 1) { fprintf(stderr, "kernel_launch: occupancy query says %d\n", per_cu); (void)hipGetLastError(); per_cu = 1; }
        grid = cus * per_cu;
    }
    if (grid < 0) return;
    Args a{};
    for (int i = 0; i < 16; ++i) a.in[i] = (const float*)d_in[i];
    a.out = (float*)d_out; a.ws = (unsigned char*)d_ws;
#ifndef MK_RMASK
#define MK_RMASK 0x3ff
#endif
    a.rmask = MK_RMASK;
#if MK_PER_PHASE
    for (int ph = 0; ph < NPHASES; ++ph) { a.ph_lo = ph; a.ph_hi = ph + 1; hipLaunchKernelGGL(mk_fwd, dim3(grid), dim3(NTHREADS), LDS_BYTES, stream, a); }
#if defined(MK_PROBE)
    hipLaunchKernelGGL(probe_kernel, dim3(2048), dim3(256), 0, stream, (float*)d_out, (const unsigned char*)d_ws);
#endif
#else
    a.ph_lo = 0; a.ph_hi = NPHASES;
    if (hipMemsetAsync((char*)d_ws + WS_BAR, 0, WS_BAR_BYTES, stream) != hipSuccess) { fprintf(stderr, "kernel_launch: hipMemsetAsync of the barrier words failed\n"); return; }
    void* kargs[] = {(void*)&a};
    hipError_t e = hipLaunchCooperativeKernel((const void*)mk_fwd, dim3(grid), dim3(NTHREADS), kargs, LDS_BYTES, stream);
    if (e != hipSuccess) fprintf(stderr, "kernel_launch: cooperative launch failed: %s (grid %d)\n", hipGetErrorString(e), grid);
#endif
}
```

```cpp
#include <hip/hip_runtime.h>
#include <hip/hip_bf16.h>
#include <hip/hip_cooperative_groups.h>
#include <cstdio>
#include <cstdint>
#include <cmath>
namespace cg = cooperative_groups;
namespace pg8 {
#define PG8_LAS __attribute__((address_space(3)))
typedef unsigned short bf16_t;
typedef short bf16x8 __attribute__((ext_vector_type(8)));
typedef float f32x4 __attribute__((ext_vector_type(4)));
typedef unsigned u32x4 __attribute__((ext_vector_type(4)));
constexpr int BM = 256, BK = 64, HALF = 128, HTB = HALF * BK * 2  , STAGE_BYTES = 8 * HTB, NXCD = 8, WGM = 8;

__host__ __device__ __forceinline__ int lds_byte(int r, int c) { const int st = (r >> 4) * 2 + (c >> 5), rr = r & 15, cc = c & 31, ob = rr * 64 + cc * 2; return st * 1024 + (ob ^ (((ob >> 9) & 1) << 5)); }
__host__ __device__ __forceinline__ void stage_rc(int b, int& R, int& C) { const int st = b / 1024, sb = b % 1024, swz = sb ^ (((sb >> 9) & 1) << 5); R = (st >> 1) * 16 + swz / 64; C = (st & 1) * 32 + (swz % 64) / 2; }
__host__ __device__ __forceinline__ int perm32(int rho) { const int n = rho >> 4, i = rho & 15; return 8 * (i >> 2) + 4 * n + (i & 3); }

struct Unit { int pm, pn; };
struct Gemm { const bf16_t* A; const bf16_t* Bt; int M, N, K; };

struct StaticOrder {
    int nM, nN, nwg, G, c;
    __host__ __device__ void init(int M, int N, int G_, int c_) { nM = M / BM; nN = N / BM; nwg = nM * nN; G = G_; c = c_; }
    __host__ __device__ bool next(int i, Unit& u) const {
        const long L = (long)i * G + c; if (L >= nwg) return false;
        int wgid = (int)L; { const int q = nwg / NXCD, r = nwg % NXCD, xcd = wgid % NXCD, off = wgid / NXCD; wgid = (xcd < r ? xcd * (q + 1) : r * (q + 1) + (xcd - r) * q) + off; }
        const int nig = WGM * nN, gid = wgid / nig, fm = gid * WGM, gsz = (nM - fm) < WGM ? (nM - fm) : WGM;
        u.pm = fm + ((wgid % nig) % gsz); u.pn = (wgid % nig) / gsz; return true;
    }
    __device__ __forceinline__ void a_ready(const Unit&) const {}
    __device__ __forceinline__ void done(const Unit&) const {}
};
typedef float cvt_f32x2_t __attribute__((ext_vector_type(2))); typedef __bf16 cvt_bf16x2_t __attribute__((ext_vector_type(2)));
__device__ __forceinline__ unsigned cvt_pk_bf16(float lo, float hi) { cvt_f32x2_t v = {lo, hi}; cvt_bf16x2_t b = __builtin_convertvector(v, cvt_bf16x2_t); return __builtin_bit_cast(unsigned, b); }
typedef float f32x2 __attribute__((ext_vector_type(2)));
typedef unsigned u32x2 __attribute__((ext_vector_type(2)));
__device__ __forceinline__ float bflo(unsigned w) { return __uint_as_float(w << 16); }
__device__ __forceinline__ float bfhi(unsigned w) { return __uint_as_float(w & 0xffff0000u); }
__device__ __forceinline__ float sigmoidf_fast(float v) { return __builtin_amdgcn_rcpf(1.0f + __builtin_amdgcn_exp2f(-1.4426950408889634f * v)); }
__device__ __forceinline__ u32x4 pack8(const f32x4 v0, const f32x4 v1) { u32x4 w; w.x = cvt_pk_bf16(v0[0], v0[1]); w.y = cvt_pk_bf16(v0[2], v0[3]); w.z = cvt_pk_bf16(v1[0], v1[1]); w.w = cvt_pk_bf16(v1[2], v1[3]); return w; }

struct EpiZ {
    static constexpr bool PERM = true, AFTER_DRAIN = false;
    bf16_t *Q, *K, *V, *FT, *GA, *GF; const float* inv_rms; const float* rope;
    __device__ __forceinline__ void operator()(const f32x4 (&acc)[2][2][4][2], const Unit& u, int wr, int wc, int fr, int fq) const {
        const int pn = u.pn, row0 = u.pm * BM + wr * 64 + fr, cl0 = wc * 32 + 8 * fq;
        if (pn < 12) {
            bf16_t* base = (pn < 6 ? Q : K) + (pn % 6) * 256 + cl0;
#pragma unroll
            for (int ai = 0; ai < 2; ++ai)
#pragma unroll
                for (int m = 0; m < 4; ++m) {
                    const int row = row0 + ai * HALF + m * 16; const float rs = inv_rms[row];
                    f32x4 cs[4];
                    if (wc == 0) { const f32x4* rp = (const f32x4*)(rope + (size_t)(row & 4095) * 32 + (fq & 1) * 16);
#pragma unroll
                        for (int t = 0; t < 4; ++t) cs[t] = rp[t]; }
#pragma unroll
                    for (int bj = 0; bj < 2; ++bj) {
                        f32x4 v0 = acc[ai][bj][m][0] * rs, v1 = acc[ai][bj][m][1] * rs;
                        if (wc == 0) {
                            const float sg = (fq < 2) ? -1.f : 1.f;
#pragma unroll
                            for (int i = 0; i < 4; ++i) {
                                const float p0 = __shfl_xor(v0[i], 32), p1 = __shfl_xor(v1[i], 32);
                                const float c0 = cs[i >> 1][(i & 1) * 2], s0 = cs[i >> 1][(i & 1) * 2 + 1];
                                const float c1 = cs[2 + (i >> 1)][(i & 1) * 2], s1 = cs[2 + (i >> 1)][(i & 1) * 2 + 1];
                                v0[i] = v0[i] * c0 + sg * p0 * s0; v1[i] = v1[i] * c1 + sg * p1 * s1;
                            }
                        }
                        *(u32x4*)(base + (size_t)row * 1536 + bj * HALF) = pack8(v0, v1);
                    }
                }
        } else if (pn < 18) {
            bf16_t* base = V + (pn - 12) * 256 + cl0;
#pragma unroll
            for (int ai = 0; ai < 2; ++ai)
#pragma unroll
                for (int m = 0; m < 4; ++m) { const int row = row0 + ai * HALF + m * 16; const float rs = inv_rms[row];
#pragma unroll
                    for (int bj = 0; bj < 2; ++bj) *(u32x4*)(base + (size_t)row * 1536 + bj * HALF) = pack8(acc[ai][bj][m][0] * rs, acc[ai][bj][m][1] * rs); }
        } else if (pn < 20) {
            bf16_t* base = FT + (pn - 18) * 256 + cl0;
#pragma unroll
            for (int ai = 0; ai < 2; ++ai)
#pragma unroll
                for (int m = 0; m < 4; ++m) { const int row = row0 + ai * HALF + m * 16; const float rs = inv_rms[row];
#pragma unroll
                    for (int bj = 0; bj < 2; ++bj) *(u32x4*)(base + (size_t)row * 512 + bj * HALF) = pack8(acc[ai][bj][m][0] * rs, acc[ai][bj][m][1] * rs); }
        } else {
            bf16_t* base = (pn < 28 ? GA + (pn - 20) * 256 : GF + (pn - 28) * 256) + cl0;
#pragma unroll
            for (int ai = 0; ai < 2; ++ai)
#pragma unroll
                for (int m = 0; m < 4; ++m) { const int row = row0 + ai * HALF + m * 16; const float rs = inv_rms[row];
#pragma unroll
                    for (int bj = 0; bj < 2; ++bj) { f32x4 v0 = acc[ai][bj][m][0] * rs, v1 = acc[ai][bj][m][1] * rs;
#pragma unroll
                        for (int i = 0; i < 4; ++i) { v0[i] = sigmoidf_fast(v0[i]); v1[i] = sigmoidf_fast(v1[i]); }
                        *(u32x4*)(base + (size_t)row * 2048 + bj * HALF) = pack8(v0, v1); } }
        }
    }
};

struct EpiDft {
    static constexpr bool PERM = true, AFTER_DRAIN = false;
    bf16_t* G;
    __device__ __forceinline__ void operator()(const f32x4 (&acc)[2][2][4][2], const Unit& u, int wr, int wc, int fr, int fq) const {
        const int part = u.pm >> 3, parity = (u.pm >> 2) & 1, kk0 = (u.pm & 3) * BM + wr * 64 + fr, pn = u.pn & 7, b = pn >> 1, col0 = part * 512 + (pn & 1) * 256 + wc * 32 + 8 * fq;
        const unsigned sgn = part ? 0x80008000u : 0u;
#pragma unroll
        for (int ai = 0; ai < 2; ++ai)
#pragma unroll
            for (int m = 0; m < 4; ++m) { const int k = 2 * (kk0 + ai * HALF + m * 16) + parity; const size_t row = (size_t)b * 4096 + k, rowm = (size_t)b * 4096 + (4096 - k);
#pragma unroll
                for (int bj = 0; bj < 2; ++bj) { const u32x4 w = pack8(acc[ai][bj][m][0], acc[ai][bj][m][1]);
                    *(u32x4*)(G + row * 1024 + col0 + bj * HALF) = w;
                    if (k > 0) { u32x4 wm; wm.x = w.x ^ sgn; wm.y = w.y ^ sgn; wm.z = w.z ^ sgn; wm.w = w.w ^ sgn; *(u32x4*)(G + rowm * 1024 + col0 + bj * HALF) = wm; } } }
    }
};
struct DftOrder {
    StaticOrder S0;
    __device__ __forceinline__ bool next(int i, Unit& u) const { if (!S0.next(i, u)) return false; u.pn += 8 * ((u.pm >> 2) & 1); return true; }
    __device__ __forceinline__ void a_ready(const Unit&) const {}
    __device__ __forceinline__ void done(const Unit&) const {}
};

struct EpiGateA {
    static constexpr bool PERM = true, AFTER_DRAIN = false;
    const bf16_t* GA; bf16_t* P1;
    __device__ __forceinline__ void operator()(const f32x4 (&acc)[2][2][4][2], const Unit& u, int wr, int wc, int fr, int fq) const {
        const int row0 = u.pm * BM + wr * 64 + fr, col0 = u.pn * BM + wc * 32 + 8 * fq;
#pragma unroll
        for (int ai = 0; ai < 2; ++ai)
#pragma unroll
            for (int m = 0; m < 4; ++m)
#pragma unroll
                for (int bj = 0; bj < 2; ++bj) { const size_t off = (size_t)(row0 + ai * HALF + m * 16) * 2048 + col0 + bj * HALF;
                    const u32x4 g = *(const u32x4*)(GA + off); const f32x4 a0 = acc[ai][bj][m][0], a1 = acc[ai][bj][m][1]; u32x4 w;
                    w.x = cvt_pk_bf16(a0[0] * bflo(g.x), a0[1] * bfhi(g.x)); w.y = cvt_pk_bf16(a0[2] * bflo(g.y), a0[3] * bfhi(g.y));
                    w.z = cvt_pk_bf16(a1[0] * bflo(g.z), a1[1] * bfhi(g.z)); w.w = cvt_pk_bf16(a1[2] * bflo(g.w), a1[3] * bfhi(g.w));
                    *(u32x4*)(P1 + off) = w; }
    }
};
struct EpiGateF {
    static constexpr bool PERM = true, AFTER_DRAIN = false;
    const bf16_t* GF; const bf16_t* P1; bf16_t* MG;
    __device__ __forceinline__ void operator()(const f32x4 (&acc)[2][2][4][2], const Unit& u, int wr, int wc, int fr, int fq) const {
        const int row0 = u.pm * BM + wr * 64 + fr, col0 = u.pn * BM + wc * 32 + 8 * fq;
#pragma unroll
        for (int ai = 0; ai < 2; ++ai)
#pragma unroll
            for (int m = 0; m < 4; ++m)
#pragma unroll
                for (int bj = 0; bj < 2; ++bj) { const size_t off = (size_t)(row0 + ai * HALF + m * 16) * 2048 + col0 + bj * HALF;
                    const u32x4 g = *(const u32x4*)(GF + off); const u32x4 p = *(const u32x4*)(P1 + off); const f32x4 a0 = acc[ai][bj][m][0], a1 = acc[ai][bj][m][1]; u32x4 w;
                    w.x = cvt_pk_bf16(bflo(p.x) + a0[0] * bflo(g.x), bfhi(p.x) + a0[1] * bfhi(g.x)); w.y = cvt_pk_bf16(bflo(p.y) + a0[2] * bflo(g.y), bfhi(p.y) + a0[3] * bfhi(g.y));
                    w.z = cvt_pk_bf16(bflo(p.z) + a1[0] * bflo(g.z), bfhi(p.z) + a1[1] * bfhi(g.z)); w.w = cvt_pk_bf16(bflo(p.w) + a1[2] * bflo(g.w), bfhi(p.w) + a1[3] * bfhi(g.w));
                    *(u32x4*)(MG + off) = w; }
    }
};
template <bool WITH_XG> struct EpiRes {
    static constexpr bool PERM = false, AFTER_DRAIN = false;
    const float* base; float* out; bf16_t* xg; const float* gvec; float* rowss;
    __device__ __forceinline__ void operator()(const f32x4 (&acc)[2][2][4][2], const Unit& u, int wr, int wc, int fr, int fq) const {
        const int row0 = u.pm * BM + wr * 64 + fr, col0 = u.pn * BM + wc * 32 + 4 * fq;
        f32x4 gv[2][2];
        if (WITH_XG) {
#pragma unroll
            for (int bj = 0; bj < 2; ++bj)
#pragma unroll
                for (int n = 0; n < 2; ++n) gv[bj][n] = *(const f32x4*)(gvec + col0 + bj * HALF + n * 16); }
#pragma unroll
        for (int ai = 0; ai < 2; ++ai)
#pragma unroll
            for (int m = 0; m < 4; ++m) { const int row = row0 + ai * HALF + m * 16; const size_t off = (size_t)row * 2048 + col0; float ss = 0.f;
#pragma unroll
                for (int bj = 0; bj < 2; ++bj)
#pragma unroll
                    for (int n = 0; n < 2; ++n) { const f32x4 v = *(const f32x4*)(base + off + bj * HALF + n * 16) + acc[ai][bj][m][n];
                        *(f32x4*)(out + off + bj * HALF + n * 16) = v; ss += (v[0] * v[0] + v[1] * v[1]) + (v[2] * v[2] + v[3] * v[3]);
                        if (WITH_XG) { const f32x4 t = v * gv[bj][n]; u32x2 w; w.x = cvt_pk_bf16(t[0], t[1]); w.y = cvt_pk_bf16(t[2], t[3]); *(u32x2*)(xg + off + bj * HALF + n * 16) = w; } }
                ss += __shfl_xor(ss, 16); ss += __shfl_xor(ss, 32);
                if (fq == 0) atomicAdd(rowss + row, ss); }
    }
};
struct EpiSwiGLU {
    static constexpr bool PERM = true, AFTER_DRAIN = false;
    bf16_t* U; const float* rowss;
    __device__ __forceinline__ void operator()(const f32x4 (&acc)[2][2][4][2], const Unit& u, int wr, int wc, int fr, int fq) const {
        const int row0 = u.pm * BM + wr * 64 + fr, ucol0 = u.pn * 128 + wc * 16 + 4 * fq;
#pragma unroll
        for (int ai = 0; ai < 2; ++ai)
#pragma unroll
            for (int m = 0; m < 4; ++m) { const int row = row0 + ai * HALF + m * 16; const float rs = __builtin_amdgcn_rsqf(rowss[row] * (1.0f / 2048.0f) + 1e-5f);
#pragma unroll
                for (int bj = 0; bj < 2; ++bj) { const f32x4 g = acc[ai][bj][m][0] * rs, up = acc[ai][bj][m][1] * rs; f32x4 s;
#pragma unroll
                    for (int i = 0; i < 4; ++i) s[i] = g[i] * sigmoidf_fast(g[i]) * up[i];
                    u32x2 w; w.x = cvt_pk_bf16(s[0], s[1]); w.y = cvt_pk_bf16(s[2], s[3]);
                    *(u32x2*)(U + (size_t)row * 5632 + ucol0 + bj * 64) = w; } }
    }
};

template <class Epi, class Sched, bool ALIGN_EPI = false, bool SP2 = false>
__device__ __forceinline__ void gemm_phase(PG8_LAS unsigned char* lds, const Gemm g, const Sched& S, const Epi& E) {
    int tid_ = threadIdx.x; asm volatile("" : "+v"(tid_));
    const int tid = tid_, wid = __builtin_amdgcn_readfirstlane(tid >> 6), lane = tid & 63, wr = wid >> 2, wc = wid & 3, fr = lane & 15, fq = lane >> 4;
    const int K = g.K, nt = K / BK;
    unsigned voffA[2], voffB[2];
#pragma unroll
    for (int i = 0; i < 2; ++i) { int R, C; stage_rc(tid * 16 + i * 8192, R, C); const int Rb = Epi::PERM ? ((R & ~31) + perm32(R & 31)) : R;
        voffA[i] = (unsigned)(R * K + C) * 2u; voffB[i] = (unsigned)(Rb * K + C) * 2u; }
    const size_t kstep = (size_t)(BK * 2);
    const size_t hstep = (size_t)HALF * K * 2;
    const size_t tstep = 2 * hstep;
    const unsigned ldsw = (unsigned)wid * 1024u;
    const int aoff = lds_byte(wr * 64 + fr, fq * 8), boff = lds_byte(wc * 32 + fr, fq * 8);
#define PG8_SA(b, h) (((b) * 2 + (h)) * HTB)
#define PG8_SB(b, h) ((4 + (b) * 2 + (h)) * HTB)
#define PG8_STAGE(bufoff, gbase, voff) do { _Pragma("unroll") for (int _i = 0; _i < 2; ++_i) \
        __builtin_amdgcn_global_load_lds((const unsigned*)((const char*)(gbase) + (voff)[_i]), (PG8_LAS unsigned*)(lds + (bufoff) + ldsw + _i * 8192), 16, 0, 0); } while (0)
#define PG8_LDA(dst, b, h) do { _Pragma("unroll") for (int m = 0; m < 4; ++m) _Pragma("unroll") for (int k = 0; k < 2; ++k) dst[m][k] = *(const PG8_LAS bf16x8*)(lds + PG8_SA(b, h) + aoff + m * 2048 + k * 1024); } while (0)
#define PG8_LDB(dst, b, h) do { _Pragma("unroll") for (int n = 0; n < 2; ++n) _Pragma("unroll") for (int k = 0; k < 2; ++k) dst[n][k] = *(const PG8_LAS bf16x8*)(lds + PG8_SB(b, h) + boff + n * 2048 + k * 1024); } while (0)
#define PG8_MMA(ai, bj, At, Bt) do { __builtin_amdgcn_s_setprio(1); _Pragma("unroll") for (int m = 0; m < 4; ++m) _Pragma("unroll") for (int n = 0; n < 2; ++n) _Pragma("unroll") for (int k = 0; k < 2; ++k) \
        acc[ai][bj][m][n] = __builtin_amdgcn_mfma_f32_16x16x32_bf16(Bt[n][k], At[m][k], acc[ai][bj][m][n], 0, 0, 0); __builtin_amdgcn_s_setprio(0); } while (0)
#define PG8_WAIT_V(n) asm volatile("s_waitcnt vmcnt(" #n ")" ::: "memory")
#define PG8_WAIT_L(n) asm volatile("s_waitcnt lgkmcnt(" #n ")" ::: "memory")
#define PG8_BAR __builtin_amdgcn_s_barrier()
#define PG8_SCHED __builtin_amdgcn_sched_barrier(0)
    Unit cur, nxt; int ui = 0;
    if (!S.next(0, cur)) return;
    f32x4 acc[2][2][4][2];
#pragma unroll
    for (int a = 0; a < 2; ++a)
#pragma unroll
        for (int b = 0; b < 2; ++b)
#pragma unroll
            for (int m = 0; m < 4; ++m)
#pragma unroll
                for (int n = 0; n < 2; ++n) acc[a][b][m][n] = (f32x4){0.f, 0.f, 0.f, 0.f};
    bf16x8 At[4][2], B0[2][2], B1[2][2];
    const char* cA = (const char*)g.A + (size_t)cur.pm * tstep; const char* cB = (const char*)g.Bt + (size_t)cur.pn * tstep;
    S.a_ready(cur);
    if constexpr (SP2) {
        PG8_STAGE(PG8_SB(0, 0), cB, voffB); PG8_STAGE(PG8_SB(0, 1), cB + hstep, voffB); PG8_STAGE(PG8_SA(0, 0), cA, voffA); PG8_STAGE(PG8_SA(0, 1), cA + hstep, voffA);
        if (wr == 1) PG8_BAR;
        PG8_WAIT_V(2); PG8_BAR;
        PG8_STAGE(PG8_SB(1, 0), cB + kstep, voffB); PG8_STAGE(PG8_SA(1, 0), cA + kstep, voffA); PG8_STAGE(PG8_SB(1, 1), cB + hstep + kstep, voffB);
        PG8_WAIT_V(6); PG8_BAR;
    } else {
        PG8_STAGE(PG8_SB(0, 0), cB, voffB); PG8_STAGE(PG8_SA(0, 0), cA, voffA); PG8_STAGE(PG8_SB(0, 1), cB + hstep, voffB); PG8_STAGE(PG8_SA(0, 1), cA + hstep, voffA);
        if (wr == 1) PG8_BAR;
        PG8_WAIT_V(4); PG8_BAR;
        PG8_STAGE(PG8_SB(1, 0), cB + kstep, voffB); PG8_STAGE(PG8_SA(1, 0), cA + kstep, voffA); PG8_STAGE(PG8_SB(1, 1), cB + hstep + kstep, voffB);
        PG8_WAIT_V(6); PG8_BAR;
    }
    for (;;) {
        const bool has_next = S.next(ui + 1, nxt);
        const char* nA = has_next ? (const char*)g.A + (size_t)nxt.pm * tstep : cA; const char* nB = has_next ? (const char*)g.Bt + (size_t)nxt.pn * tstep : cB;
        for (int t = 0; t < nt; t += 2) {
            const bool last = (t == nt - 2);
            const char* a1 = cA + (size_t)(t + 1) * kstep;
            const char* a2 = last ? nA : cA + (size_t)(t + 2) * kstep; const char* b2 = last ? nB : cB + (size_t)(t + 2) * kstep;
            const char* a3 = a2 + kstep; const char* b3 = b2 + kstep;
            if (last && has_next) S.a_ready(nxt);
            if constexpr (SP2) {
            PG8_LDB(B0, 0, 0); PG8_LDB(B1, 0, 1); PG8_SCHED; PG8_LDA(At, 0, 0); PG8_STAGE(PG8_SA(1, 1), a1 + hstep, voffA);
            PG8_WAIT_V(8); PG8_WAIT_L(0); PG8_BAR; PG8_MMA(0, 0, At, B0); PG8_MMA(0, 1, At, B1); PG8_BAR; PG8_SCHED;
            PG8_LDA(At, 0, 1); PG8_STAGE(PG8_SB(0, 0), b2, voffB); PG8_STAGE(PG8_SB(0, 1), b2 + hstep, voffB); PG8_STAGE(PG8_SA(0, 0), a2, voffA);
            PG8_WAIT_V(8); PG8_WAIT_L(0); PG8_BAR; PG8_MMA(1, 0, At, B0); PG8_MMA(1, 1, At, B1); PG8_BAR; PG8_SCHED;
            PG8_LDB(B0, 1, 0); PG8_LDB(B1, 1, 1); PG8_SCHED; PG8_LDA(At, 1, 0); PG8_STAGE(PG8_SA(0, 1), a2 + hstep, voffA);
            PG8_WAIT_V(8); PG8_WAIT_L(0); PG8_BAR; PG8_MMA(0, 0, At, B0); PG8_MMA(0, 1, At, B1); PG8_BAR; PG8_SCHED;
            PG8_LDA(At, 1, 1); PG8_STAGE(PG8_SB(1, 0), b3, voffB); PG8_STAGE(PG8_SB(1, 1), b3 + hstep, voffB); PG8_STAGE(PG8_SA(1, 0), a3, voffA);
            PG8_WAIT_V(8); PG8_WAIT_L(0); PG8_BAR; PG8_MMA(1, 0, At, B0); PG8_MMA(1, 1, At, B1); PG8_BAR; PG8_SCHED;
            } else {
            PG8_LDB(B0, 0, 0); PG8_SCHED; PG8_LDA(At, 0, 0); PG8_STAGE(PG8_SA(1, 1), a1 + hstep, voffA);
            PG8_WAIT_L(8); PG8_BAR; PG8_WAIT_L(0); PG8_MMA(0, 0, At, B0); PG8_BAR; PG8_SCHED;
            PG8_LDB(B1, 0, 1); PG8_STAGE(PG8_SB(0, 0), b2, voffB);
            PG8_BAR; PG8_WAIT_L(0); PG8_MMA(0, 1, At, B1); PG8_BAR;
            PG8_LDA(At, 0, 1); PG8_STAGE(PG8_SA(0, 0), a2, voffA);
            PG8_BAR; PG8_WAIT_L(0); PG8_MMA(1, 0, At, B0); PG8_BAR; PG8_SCHED;
            PG8_STAGE(PG8_SB(0, 1), b2 + hstep, voffB);
            PG8_WAIT_V(6); PG8_BAR; PG8_MMA(1, 1, At, B1); PG8_BAR;
            PG8_LDB(B0, 1, 0); PG8_SCHED; PG8_LDA(At, 1, 0); PG8_STAGE(PG8_SA(0, 1), a2 + hstep, voffA);
            PG8_WAIT_L(8); PG8_BAR; PG8_WAIT_L(0); PG8_MMA(0, 0, At, B0); PG8_BAR; PG8_SCHED;
            PG8_LDB(B1, 1, 1); PG8_STAGE(PG8_SB(1, 0), b3, voffB);
            PG8_BAR; PG8_WAIT_L(0); PG8_MMA(0, 1, At, B1); PG8_BAR;
            PG8_LDA(At, 1, 1); PG8_STAGE(PG8_SA(1, 0), a3, voffA);
            PG8_BAR; PG8_WAIT_L(0); PG8_MMA(1, 0, At, B0); PG8_BAR; PG8_SCHED;
            PG8_STAGE(PG8_SB(1, 1), b3 + hstep, voffB);
            PG8_WAIT_V(6); PG8_BAR; PG8_MMA(1, 1, At, B1); PG8_BAR;
            }
        }
        if constexpr (ALIGN_EPI) { if (wr == 0) PG8_BAR; }
        if constexpr (!Epi::AFTER_DRAIN) { E(acc, cur, wr, wc, fr, fq); S.done(cur); }
        if (!has_next) break;
#pragma unroll
        for (int a = 0; a < 2; ++a)
#pragma unroll
            for (int b = 0; b < 2; ++b)
#pragma unroll
                for (int m = 0; m < 4; ++m)
#pragma unroll
                    for (int n = 0; n < 2; ++n) acc[a][b][m][n] = (f32x4){0.f, 0.f, 0.f, 0.f};
        cur = nxt; cA = nA; cB = nB; ++ui;
        if constexpr (ALIGN_EPI) { if (wr == 1) PG8_BAR; }
    }
    PG8_WAIT_V(0);
    if constexpr (!ALIGN_EPI) { if (wr == 0) PG8_BAR; }
    PG8_BAR;
    if constexpr (Epi::AFTER_DRAIN) { E.fused(acc, cur, wr, wc, fr, fq, lds, wid, lane); S.done(cur); }
#undef PG8_SA
#undef PG8_SB
#undef PG8_STAGE
#undef PG8_LDA
#undef PG8_LDB
#undef PG8_MMA
#undef PG8_WAIT_V
#undef PG8_WAIT_L
#undef PG8_BAR
#undef PG8_SCHED
}
}

namespace att {
using bf16 = __hip_bfloat16;
constexpr int   D = 128, NW = 8, QBLK = 32, KVBLK = 64;
constexpr float SCALE = 0.088388347648318440f;
constexpr float THR = 8.f;
#ifndef ATT_SDEPTH
#define ATT_SDEPTH 2
#endif
constexpr int SDEPTH = ATT_SDEPTH;
constexpr int LDQ = 1536, LDK = 1536, LDO = 3072;
constexpr size_t SHM_V = KVBLK * D * 2, SHM_K = KVBLK * D * 2, SHM_ATTN = 2 * SHM_V + 2 * SHM_K + NW * 64 * 4;
using bf16x8 = __attribute__((ext_vector_type(8))) short;
using s16x4  = __attribute__((ext_vector_type(4))) short;
using f32x16 = __attribute__((ext_vector_type(16))) float;
using f32x8  = __attribute__((ext_vector_type(8))) float;
using u32x4  = __attribute__((ext_vector_type(4))) unsigned;
#define KSWZ(row, colB) ((row) * 256 + ((colB) ^ (((row) & 7) << 4)))
#define SBAR() __builtin_amdgcn_sched_barrier(0)
__device__ __forceinline__ int crow(int r, int hi) { return (r & 3) + 8 * (r >> 2) + 4 * hi; }
typedef float cvt_f32x2_t __attribute__((ext_vector_type(2))); typedef __bf16 cvt_bf16x2_t __attribute__((ext_vector_type(2)));
__device__ __forceinline__ unsigned cvtpk(float lo, float hi) {
  cvt_f32x2_t v = {lo, hi}; cvt_bf16x2_t b = __builtin_convertvector(v, cvt_bf16x2_t); return __builtin_bit_cast(unsigned, b);
}
template <typename TIn> struct Stage;
template <> struct Stage<bf16>  { using T = bf16x8;
  __device__ static __forceinline__ T ld8(const bf16* p) { return *reinterpret_cast<const bf16x8*>(p); }
  __device__ static __forceinline__ bf16x8 tobf(T x) { return x; } };
template <> struct Stage<float> { using T = f32x8;
  __device__ static __forceinline__ T ld8(const float* p) { return *reinterpret_cast<const f32x8*>(p); }
  __device__ static __forceinline__ bf16x8 tobf(T x) {
    u32x4 w = {cvtpk(x[0], x[1]), cvtpk(x[2], x[3]), cvtpk(x[4], x[5]), cvtpk(x[6], x[7])}; return *reinterpret_cast<bf16x8*>(&w); } };

__device__ __forceinline__ void partialSM(f32x16& p0, f32x16& p1, float& m_reg, float& mn, float& alpha) {
  constexpr float C = SCALE * 1.4426950408889634f;
  float pmax = p0[0]; for (int r = 1; r < 16; ++r) pmax = fmaxf(pmax, p0[r]); for (int r = 0; r < 16; ++r) pmax = fmaxf(pmax, p1[r]);
  { auto rr = __builtin_amdgcn_permlane32_swap(__float_as_uint(pmax), __float_as_uint(pmax), false, false);
    pmax = fmaxf(__uint_as_float(rr[0]), __uint_as_float(rr[1])); }
  if (__builtin_expect(__all(pmax - m_reg <= THR / SCALE), 1)) { mn = m_reg; alpha = 1.f; }
  else { mn = fmaxf(m_reg, pmax); alpha = __builtin_amdgcn_exp2f((m_reg - mn) * C); m_reg = mn; }
  float mnC = -mn * C;
  for (int r = 0; r < 16; ++r) p0[r] = fmaf(p0[r], C, mnC); for (int r = 0; r < 16; ++r) p1[r] = fmaf(p1[r], C, mnC);
  for (int r = 0; r < 16; ++r) p0[r] = __builtin_amdgcn_exp2f(p0[r]);
}
__device__ __forceinline__ void finishSM(f32x16& p0, f32x16& p1, float alpha, float& l_reg, bf16x8& pa0, bf16x8& pa1, bf16x8& pa2, bf16x8& pa3) {
  for (int r = 0; r < 16; ++r) p1[r] = __builtin_amdgcn_exp2f(p1[r]);
  float ps = 0; for (int r = 0; r < 16; ++r) ps += p0[r]; for (int r = 0; r < 16; ++r) ps += p1[r];
  { auto rr = __builtin_amdgcn_permlane32_swap(__float_as_uint(ps), __float_as_uint(ps), false, false);
    ps = __uint_as_float(rr[0]) + __uint_as_float(rr[1]); }
  l_reg = l_reg * alpha + ps;
#define PK4(P, BASE, OUT) do { unsigned a0 = cvtpk(P[BASE + 0], P[BASE + 1]), a1 = cvtpk(P[BASE + 2], P[BASE + 3]);   \
    unsigned b0 = cvtpk(P[BASE + 4], P[BASE + 5]), b1 = cvtpk(P[BASE + 6], P[BASE + 7]);                              \
    auto r0 = __builtin_amdgcn_permlane32_swap(a0, b0, false, false); auto r1 = __builtin_amdgcn_permlane32_swap(a1, b1, false, false); \
    u32x4 w = {r0[0], r1[0], r0[1], r1[1]}; OUT = *reinterpret_cast<bf16x8*>(&w); } while (0)
  PK4(p0, 0, pa0); PK4(p0, 8, pa1); PK4(p1, 0, pa2); PK4(p1, 8, pa3);
#undef PK4
}
__device__ __forceinline__ void qkt(f32x16& p0, f32x16& p1, const bf16* Ks, const bf16x8* qr, int r32, int hi) {
  p0 = f32x16{}; p1 = f32x16{};
  for (int d0 = 0; d0 < 8; ++d0) { int cb = (d0 * 16 + hi * 8) * 2;
    bf16x8 b0 = *reinterpret_cast<const bf16x8*>((const char*)Ks + KSWZ(r32, cb));
    bf16x8 b1 = *reinterpret_cast<const bf16x8*>((const char*)Ks + KSWZ(32 + r32, cb));
    p0 = __builtin_amdgcn_mfma_f32_32x32x16_bf16(b0, qr[d0], p0, 0, 0, 0);
    p1 = __builtin_amdgcn_mfma_f32_32x32x16_bf16(b1, qr[d0], p1, 0, 0, 0); }
}
__device__ __forceinline__ int v_st(int k, int c) { const int kk = (k & ~0xC) | ((k & 4) << 1) | ((k & 8) >> 1); return ((kk >> 3) * 4 + (c >> 5)) * 512 + ((kk & 7) * 32 + (c & 31)) * 2; }
__device__ __forceinline__ int v_rd_base(int lane) { return ((lane & 3) << 3) | (((lane >> 2) & 3) << 6) | (((lane >> 4) & 1) << 5) | (((lane >> 5) & 1) << 8); }
constexpr int v_rd_off(int d0, int ks, int half) { return d0 * 512 + ks * 4096 + half * 2048; }
template <int OFF> __device__ __forceinline__ s16x4 tr_read(int vb) {
  s16x4 r; asm volatile("ds_read_b64_tr_b16 %0, %1 offset:%2" : "=&v"(r) : "v"(vb), "i"(OFF) : "memory"); return r;
}
template <int D0> __device__ __forceinline__ void pv_one(f32x16& od, int vb, bf16x8 pa0, bf16x8 pa1, bf16x8 pa2, bf16x8 pa3) {
  const s16x4 l0 = tr_read<v_rd_off(D0, 0, 0)>(vb), h0 = tr_read<v_rd_off(D0, 0, 1)>(vb), l1 = tr_read<v_rd_off(D0, 1, 0)>(vb), h1 = tr_read<v_rd_off(D0, 1, 1)>(vb);
  const s16x4 l2 = tr_read<v_rd_off(D0, 2, 0)>(vb), h2 = tr_read<v_rd_off(D0, 2, 1)>(vb), l3 = tr_read<v_rd_off(D0, 3, 0)>(vb), h3 = tr_read<v_rd_off(D0, 3, 1)>(vb);
  asm volatile("s_waitcnt lgkmcnt(0)" ::: "memory"); SBAR();
#define PK(L, H) (bf16x8){L[0], L[1], L[2], L[3], H[0], H[1], H[2], H[3]}
  od = __builtin_amdgcn_mfma_f32_32x32x16_bf16(pa0, PK(l0, h0), od, 0, 0, 0);
  od = __builtin_amdgcn_mfma_f32_32x32x16_bf16(pa1, PK(l1, h1), od, 0, 0, 0);
  od = __builtin_amdgcn_mfma_f32_32x32x16_bf16(pa2, PK(l2, h2), od, 0, 0, 0);
  od = __builtin_amdgcn_mfma_f32_32x32x16_bf16(pa3, PK(l3, h3), od, 0, 0, 0);
#undef PK
}
__device__ __forceinline__ void pv_d0(f32x16* o, int vb, bf16x8 pa0, bf16x8 pa1, bf16x8 pa2, bf16x8 pa3) {
  pv_one<0>(o[0], vb, pa0, pa1, pa2, pa3); pv_one<1>(o[1], vb, pa0, pa1, pa2, pa3); pv_one<2>(o[2], vb, pa0, pa1, pa2, pa3); pv_one<3>(o[3], vb, pa0, pa1, pa2, pa3);
}
template <typename TQ>
__device__ __forceinline__ void attn_dense_body(const TQ* __restrict__ Qb, const bf16* __restrict__ Kh, const bf16* __restrict__ Vh,
                                                bf16* __restrict__ Ob, int seq, char* lds) {
  using St = Stage<bf16>; using SQ = Stage<TQ>;
  int tid_ = threadIdx.x; asm volatile("" : "+v"(tid_));
  const int tid = tid_, wid = tid >> 6, lane = tid & 63, r32 = lane & 31, hi = lane >> 5;
  bf16* V_lds = (bf16*)lds; bf16* K_lds = (bf16*)(lds + 2 * SHM_V);
  float* ws = (float*)(lds + 2 * SHM_V + 2 * SHM_K) + wid * 64; float* li_l = ws; float* al_l = ws + 32;
  float m_reg = -1e30f, l_reg = 0; f32x16 o[4] = {}; bf16x8 qr[8];
  const TQ* Qw = Qb + (long)(wid * QBLK + r32) * LDQ + hi * 8;
#pragma unroll
  for (int d0 = 0; d0 < 8; ++d0) qr[d0] = SQ::tobf(SQ::ld8(Qw + d0 * 16));
  const int sr = tid >> 4, sc = (tid & 15) * 8, vst0 = v_st(sr, sc), vst1 = v_st(32 + sr, sc);
  const int vb0 = (int)(uintptr_t)V_lds + v_rd_base(lane);
  struct { typename St::T vs0, vs1, ks0, ks1; } sr_[SDEPTH];
#define SLOAD(i, k0) do { sr_[i].vs0 = St::ld8(&Vh[(long)((k0) + sr) * LDK + sc]); sr_[i].vs1 = St::ld8(&Vh[(long)((k0) + 32 + sr) * LDK + sc]); \
    sr_[i].ks0 = St::ld8(&Kh[(long)((k0) + sr) * LDK + sc]); sr_[i].ks1 = St::ld8(&Kh[(long)((k0) + 32 + sr) * LDK + sc]); } while (0)
#define SWRITE(b, i) do { *(bf16x8*)((char*)V_lds + (b) * SHM_V + vst0) = St::tobf(sr_[i].vs0);          \
    *(bf16x8*)((char*)V_lds + (b) * SHM_V + vst1) = St::tobf(sr_[i].vs1); int kc = sc * 2;               \
    *(bf16x8*)((char*)K_lds + (b) * SHM_K + KSWZ(sr, kc)) = St::tobf(sr_[i].ks0);                       \
    *(bf16x8*)((char*)K_lds + (b) * SHM_K + KSWZ(32 + sr, kc)) = St::tobf(sr_[i].ks1); } while (0)
#define SWAIT() do { if constexpr (SDEPTH == 2) asm volatile("s_waitcnt vmcnt(4)" ::: "memory"); else asm volatile("s_waitcnt vmcnt(0)" ::: "memory"); } while (0)
#define RESC(a) do { if (__any((a) < 1.f)) { if (hi == 0) al_l[r32] = (a); asm volatile("s_waitcnt lgkmcnt(0)" ::: "memory"); \
    for (int d = 0; d < 4; ++d) for (int r = 0; r < 16; ++r) o[d][r] *= al_l[crow(r, hi)]; } } while (0)
  f32x16 pA0, pA1, pB0, pB1; float mnA, mnB, alA, alB; bf16x8 pa0, pa1, pa2, pa3; const int NT = seq / KVBLK;
  constexpr int SE = 0, SO = SDEPTH - 1;
  SLOAD(SE, 0); asm volatile("s_waitcnt vmcnt(0)" ::: "memory"); SWRITE(0, SE); __syncthreads();
  qkt(pA0, pA1, K_lds, qr, r32, hi); partialSM(pA0, pA1, m_reg, mnA, alA);
  SLOAD(SO, KVBLK); if constexpr (SDEPTH == 2) { if (2 < NT) SLOAD(SE, 2 * KVBLK); }
  SWAIT(); SWRITE(1, SO); __syncthreads();
  for (int j = 1; j + 1 < NT; j += 2) {
    SBAR(); qkt(pB0, pB1, (bf16*)((char*)K_lds + SHM_K), qr, r32, hi);
    finishSM(pA0, pA1, alA, l_reg, pa0, pa1, pa2, pa3); SBAR();
    SLOAD(SO, (j + SDEPTH) * KVBLK); SBAR();
    pv_d0(o, vb0, pa0, pa1, pa2, pa3); partialSM(pB0, pB1, m_reg, mnB, alB);
    __syncthreads(); SWAIT(); SWRITE(0, SE);
    RESC(alB); __syncthreads();
    SBAR(); qkt(pA0, pA1, K_lds, qr, r32, hi);
    finishSM(pB0, pB1, alB, l_reg, pa0, pa1, pa2, pa3); SBAR();
    if (SDEPTH == 1 || j + 3 < NT) SLOAD(SE, (j + 1 + SDEPTH) * KVBLK); SBAR();
    pv_d0(o, vb0 + (int)SHM_V, pa0, pa1, pa2, pa3); partialSM(pA0, pA1, m_reg, mnA, alA);
    __syncthreads(); SWAIT(); SWRITE(1, SO);
    RESC(alA); __syncthreads();
  }
  SBAR(); qkt(pB0, pB1, (bf16*)((char*)K_lds + SHM_K), qr, r32, hi);
  finishSM(pA0, pA1, alA, l_reg, pa0, pa1, pa2, pa3); SBAR();
  pv_d0(o, vb0, pa0, pa1, pa2, pa3); partialSM(pB0, pB1, m_reg, mnB, alB);
  __syncthreads(); RESC(alB);
  finishSM(pB0, pB1, alB, l_reg, pa0, pa1, pa2, pa3); SBAR();
  pv_d0(o, vb0 + (int)SHM_V, pa0, pa1, pa2, pa3);
  if (hi == 0) li_l[r32] = l_reg; asm volatile("s_waitcnt lgkmcnt(0)" ::: "memory");
  float rli[16];
#pragma unroll
  for (int r = 0; r < 16; ++r) rli[r] = __builtin_amdgcn_rcpf(li_l[crow(r, hi)]);
  bf16* Ow = Ob + (long)(wid * QBLK) * LDO;
#pragma unroll
  for (int r = 0; r < 16; ++r) { int orow = crow(r, hi);
    for (int d0 = 0; d0 < 4; ++d0) Ow[(long)orow * LDO + d0 * 32 + r32] = __float2bfloat16(o[d0][r] * rli[r]); }
#undef SLOAD
#undef SWRITE
#undef SWAIT
#undef RESC
}

constexpr int PC_K = 0, PC_V = 32768, PC_XP = 98304, PC_XAL = 131072, PC_LI = 133120, PC_LDS_BYTES = 133632;
struct PCStage { bf16x8 k0, k1, v00, v01, v10, v11; };
__device__ __forceinline__ void pc_sload(PCStage& st, const bf16* __restrict__ Kh, const bf16* __restrict__ Vh, bool doK, int kK, bool doV, int kV, int sr, int sc) {
  if (doK) { st.k0  = *reinterpret_cast<const bf16x8*>(Kh + (long)(kK + sr) * LDK + sc);       st.k1  = *reinterpret_cast<const bf16x8*>(Kh + (long)(kK + 32 + sr) * LDK + sc); }
  if (doV) { st.v00 = *reinterpret_cast<const bf16x8*>(Vh + (long)(kV + sr) * LDK + sc);       st.v01 = *reinterpret_cast<const bf16x8*>(Vh + (long)(kV + 32 + sr) * LDK + sc);
             st.v10 = *reinterpret_cast<const bf16x8*>(Vh + (long)(kV + sr) * LDK + 128 + sc); st.v11 = *reinterpret_cast<const bf16x8*>(Vh + (long)(kV + 32 + sr) * LDK + 128 + sc); }
}
__device__ __forceinline__ void pc_swrite(const PCStage& st, char* lds, bool doK, int kbuf, bool doV, int vbuf, int sr, int sc, int vst0, int vst1) {
  if (doK) { char* K_ = lds + PC_K + kbuf * 16384; const int kc = sc * 2;
    *reinterpret_cast<bf16x8*>(K_ + KSWZ(sr, kc)) = st.k0; *reinterpret_cast<bf16x8*>(K_ + KSWZ(32 + sr, kc)) = st.k1; }
  if (doV) { char* V0 = lds + PC_V + (vbuf * 2) * 16384; char* V1 = V0 + 16384;
    *reinterpret_cast<bf16x8*>(V0 + vst0) = st.v00; *reinterpret_cast<bf16x8*>(V0 + vst1) = st.v01;
    *reinterpret_cast<bf16x8*>(V1 + vst0) = st.v10; *reinterpret_cast<bf16x8*>(V1 + vst1) = st.v11; }
}
__device__ __forceinline__ void pc_consume(f32x16 (&o)[8], char* lds, int vbase, int pbuf, int pw, int lane, int hi) {
  const float* xa = reinterpret_cast<const float*>(lds + PC_XAL + (pbuf * 4 + pw) * 256);
  if (__builtin_amdgcn_readfirstlane(__float_as_int(xa[32])) != 0) {
#pragma unroll
    for (int r = 0; r < 16; ++r) { const float a = xa[crow(r, hi)];
#pragma unroll
      for (int d = 0; d < 8; ++d) o[d][r] *= a; }
  }
  const u32x4* xp = reinterpret_cast<const u32x4*>(lds + PC_XP + (pbuf * 4 + pw) * 4096) + lane;
  const u32x4 w0 = xp[0], w1 = xp[64], w2 = xp[128], w3 = xp[192];
  const bf16x8 pa0 = __builtin_bit_cast(bf16x8, w0), pa1 = __builtin_bit_cast(bf16x8, w1), pa2 = __builtin_bit_cast(bf16x8, w2), pa3 = __builtin_bit_cast(bf16x8, w3);
  const int vb0 = vbase + (pbuf * 2) * 16384, vb1 = vb0 + 16384;
  pv_one<0>(o[0], vb0, pa0, pa1, pa2, pa3); pv_one<1>(o[1], vb0, pa0, pa1, pa2, pa3); pv_one<2>(o[2], vb0, pa0, pa1, pa2, pa3); pv_one<3>(o[3], vb0, pa0, pa1, pa2, pa3);
  pv_one<0>(o[4], vb1, pa0, pa1, pa2, pa3); pv_one<1>(o[5], vb1, pa0, pa1, pa2, pa3); pv_one<2>(o[6], vb1, pa0, pa1, pa2, pa3); pv_one<3>(o[7], vb1, pa0, pa1, pa2, pa3);
}
template <int D0> __device__ __forceinline__ void pv_two(f32x16& oa, f32x16& ob, int vb, bf16x8 a0, bf16x8 a1, bf16x8 a2, bf16x8 a3, bf16x8 b0, bf16x8 b1, bf16x8 b2, bf16x8 b3) {
  const s16x4 l0 = tr_read<v_rd_off(D0, 0, 0)>(vb), h0 = tr_read<v_rd_off(D0, 0, 1)>(vb), l1 = tr_read<v_rd_off(D0, 1, 0)>(vb), h1 = tr_read<v_rd_off(D0, 1, 1)>(vb);
  const s16x4 l2 = tr_read<v_rd_off(D0, 2, 0)>(vb), h2 = tr_read<v_rd_off(D0, 2, 1)>(vb), l3 = tr_read<v_rd_off(D0, 3, 0)>(vb), h3 = tr_read<v_rd_off(D0, 3, 1)>(vb);
  asm volatile("s_waitcnt lgkmcnt(0)" ::: "memory"); SBAR();
#define PK(L, H) (bf16x8){L[0], L[1], L[2], L[3], H[0], H[1], H[2], H[3]}
  oa = __builtin_amdgcn_mfma_f32_32x32x16_bf16(a0, PK(l0, h0), oa, 0, 0, 0); ob = __builtin_amdgcn_mfma_f32_32x32x16_bf16(b0, PK(l0, h0), ob, 0, 0, 0);
  oa = __builtin_amdgcn_mfma_f32_32x32x16_bf16(a1, PK(l1, h1), oa, 0, 0, 0); ob = __builtin_amdgcn_mfma_f32_32x32x16_bf16(b1, PK(l1, h1), ob, 0, 0, 0);
  oa = __builtin_amdgcn_mfma_f32_32x32x16_bf16(a2, PK(l2, h2), oa, 0, 0, 0); ob = __builtin_amdgcn_mfma_f32_32x32x16_bf16(b2, PK(l2, h2), ob, 0, 0, 0);
  oa = __builtin_amdgcn_mfma_f32_32x32x16_bf16(a3, PK(l3, h3), oa, 0, 0, 0); ob = __builtin_amdgcn_mfma_f32_32x32x16_bf16(b3, PK(l3, h3), ob, 0, 0, 0);
#undef PK
}
__device__ __forceinline__ void pc_consume2(f32x16 (&o)[8], char* lds, int vbh  , int pbuf, int rg2, int lane, int hi) {
  const int sa = pbuf * 4 + 2 * rg2;
  const float* xaA = reinterpret_cast<const float*>(lds + PC_XAL + sa * 256); const float* xaB = xaA + 64;
  if (__builtin_amdgcn_readfirstlane(__float_as_int(xaA[32])) != 0) {
#pragma unroll
    for (int r = 0; r < 16; ++r) { const float a = xaA[crow(r, hi)];
#pragma unroll
      for (int d = 0; d < 4; ++d) o[d][r] *= a; } }
  if (__builtin_amdgcn_readfirstlane(__float_as_int(xaB[32])) != 0) {
#pragma unroll
    for (int r = 0; r < 16; ++r) { const float a = xaB[crow(r, hi)];
#pragma unroll
      for (int d = 0; d < 4; ++d) o[4 + d][r] *= a; } }
  const u32x4* xpA = reinterpret_cast<const u32x4*>(lds + PC_XP + sa * 4096) + lane; const u32x4* xpB = xpA + 256;
  const u32x4 wa0 = xpA[0], wa1 = xpA[64], wa2 = xpA[128], wa3 = xpA[192], wb0 = xpB[0], wb1 = xpB[64], wb2 = xpB[128], wb3 = xpB[192];
  const bf16x8 a0 = __builtin_bit_cast(bf16x8, wa0), a1 = __builtin_bit_cast(bf16x8, wa1), a2 = __builtin_bit_cast(bf16x8, wa2), a3 = __builtin_bit_cast(bf16x8, wa3);
  const bf16x8 b0 = __builtin_bit_cast(bf16x8, wb0), b1 = __builtin_bit_cast(bf16x8, wb1), b2 = __builtin_bit_cast(bf16x8, wb2), b3 = __builtin_bit_cast(bf16x8, wb3);
  const int vb = vbh + (pbuf * 2) * 16384;
  pv_two<0>(o[0], o[4], vb, a0, a1, a2, a3, b0, b1, b2, b3); pv_two<1>(o[1], o[5], vb, a0, a1, a2, a3, b0, b1, b2, b3);
  pv_two<2>(o[2], o[6], vb, a0, a1, a2, a3, b0, b1, b2, b3); pv_two<3>(o[3], o[7], vb, a0, a1, a2, a3, b0, b1, b2, b3);
}
__device__ __forceinline__ void attn_pc_unit(const bf16* __restrict__ Qb, const bf16* __restrict__ Kh, const bf16* __restrict__ Vh, bf16* __restrict__ Ob, char* lds, int rot) {
#define PC_KT(X) ((((X) + rot) & (NT - 1)) * KVBLK)
  int tid_ = threadIdx.x; asm volatile("" : "+v"(tid_));
  const int tid = tid_, lane = tid & 63, r32 = lane & 31, hi = lane >> 5;
  const int wid = __builtin_amdgcn_readfirstlane(tid >> 6), pw = wid & 3;
  const int sr = tid >> 4, sc = (tid & 15) * 8, vst0 = v_st(sr, sc), vst1 = v_st(32 + sr, sc);
  constexpr int NT = 4096 / KVBLK;
  PCStage st;
  pc_sload(st, Kh, Vh, true, PC_KT(0), false, 0, sr, sc); pc_swrite(st, lds, true, 0, false, 0, sr, sc, vst0, vst1);
  pc_sload(st, Kh, Vh, true, PC_KT(1), true, PC_KT(0), sr, sc);
  if (wid < 4) {
    bf16x8 qr[8]; const bf16* Qw = Qb + (long)(pw * QBLK + r32) * LDQ + hi * 8;
#pragma unroll
    for (int d0 = 0; d0 < 8; ++d0) qr[d0] = *reinterpret_cast<const bf16x8*>(Qw + d0 * 16);
    float m_reg = -1e30f, l_reg = 0.f;
    __syncthreads();
    for (int j = 0; j < NT; ++j) {
      const int buf = j & 1;
      pc_swrite(st, lds, j + 1 < NT, buf ^ 1, true, buf, sr, sc, vst0, vst1);
      pc_sload(st, Kh, Vh, j + 2 < NT, PC_KT(j + 2), j + 1 < NT, PC_KT(j + 1), sr, sc);
      f32x16 p0, p1; float mn, alpha; bf16x8 pa0, pa1, pa2, pa3;
      SBAR(); qkt(p0, p1, reinterpret_cast<const bf16*>(lds + PC_K + buf * 16384), qr, r32, hi);
      partialSM(p0, p1, m_reg, mn, alpha); finishSM(p0, p1, alpha, l_reg, pa0, pa1, pa2, pa3);
      { u32x4* xp = reinterpret_cast<u32x4*>(lds + PC_XP + (buf * 4 + pw) * 4096) + lane;
        xp[0] = __builtin_bit_cast(u32x4, pa0); xp[64] = __builtin_bit_cast(u32x4, pa1); xp[128] = __builtin_bit_cast(u32x4, pa2); xp[192] = __builtin_bit_cast(u32x4, pa3);
        float* xa = reinterpret_cast<float*>(lds + PC_XAL + (buf * 4 + pw) * 256);
        const float fl = __any(alpha < 1.f) ? 1.f : 0.f;
        if (hi == 0) xa[r32] = alpha;
        if (lane == 0) xa[32] = fl; }
      __syncthreads();
    }
    if (hi == 0) reinterpret_cast<float*>(lds + PC_LI)[pw * 32 + r32] = l_reg;
    __syncthreads();
    __syncthreads();
  } else {
    f32x16 o[8] = {};
    const int rg2 = pw & 1, vh = pw >> 1;
    const int vbh = (int)(uintptr_t)(lds + PC_V) + vh * 16384 + v_rd_base(lane);
    __syncthreads();
    for (int j = 0; j < NT; ++j) {
      const int buf = j & 1;
      pc_swrite(st, lds, j + 1 < NT, buf ^ 1, true, buf, sr, sc, vst0, vst1);
      pc_sload(st, Kh, Vh, j + 2 < NT, PC_KT(j + 2), j + 1 < NT, PC_KT(j + 1), sr, sc);
      if (j > 0) pc_consume2(o, lds, vbh, buf ^ 1, rg2, lane, hi);
      __syncthreads();
    }
    pc_consume2(o, lds, vbh, (NT - 1) & 1, rg2, lane, hi);
    __syncthreads();
    const float* li = reinterpret_cast<const float*>(lds + PC_LI) + (2 * rg2) * 32;
    float rla[16], rlb[16];
#pragma unroll
    for (int r = 0; r < 16; ++r) { rla[r] = __builtin_amdgcn_rcpf(li[crow(r, hi)]); rlb[r] = __builtin_amdgcn_rcpf(li[32 + crow(r, hi)]); }
    bf16* Ow = Ob + (long)(2 * rg2 * QBLK) * LDO + vh * 128;
#pragma unroll
    for (int r = 0; r < 16; ++r) { const int orow = crow(r, hi);
#pragma unroll
      for (int d0 = 0; d0 < 4; ++d0) { Ow[(long)orow * LDO + d0 * 32 + r32] = __float2bfloat16(o[d0][r] * rla[r]); Ow[(long)(QBLK + orow) * LDO + d0 * 32 + r32] = __float2bfloat16(o[4 + d0][r] * rlb[r]); } }
    __syncthreads();
  }
}
#undef PC_KT
#undef SBAR
#undef KSWZ
}

#ifndef MK_PER_PHASE
#define MK_PER_PHASE 0
#endif
#define GAS __attribute__((address_space(1)))
#define LAS __attribute__((address_space(3)))
typedef unsigned short bf16;
typedef unsigned v4u __attribute__((ext_vector_type(4)));
typedef unsigned v2u __attribute__((ext_vector_type(2)));
typedef float f32x4 __attribute__((ext_vector_type(4)));
#define LDS_WAIT() asm volatile("s_waitcnt lgkmcnt(0)" ::: "memory")

constexpr int NWAVES = 8, NTHREADS = 512;
constexpr int BATCH = 4, SEQ = 4096, DM = 2048, M = BATCH * SEQ;
constexpr int NH = 6, QKW = 1536, VW = 1536, FW = 512, INW = 9216, DFF = 5632;
constexpr float RMS_EPS = 1e-5f, LAMBDA_INIT = 0.2f;
constexpr int NPHASES = 10;
constexpr size_t MiB = 1u << 20;
constexpr size_t WS_INV0 = 0, WS_SS1 = 64 * 1024, WS_SS2 = 128 * 1024, WS_BAR = 192 * 1024  , WS_BAR_BYTES = 16384, WS_ROPE = 256 * 1024;
constexpr size_t WS_WIN = 1 * MiB, WS_WA = 37 * MiB, WS_WCS = 43 * MiB, WS_WOUT = 47 * MiB, WS_WGU = 55 * MiB, WS_WDN = 99 * MiB;
constexpr size_t WS_ADFT = 121 * MiB;
constexpr size_t WS_Q = 185 * MiB, WS_K = 233 * MiB, WS_V = 281 * MiB, WS_FT = 329 * MiB, WS_GA = 345 * MiB, WS_GF = 409 * MiB, WS_F = 473 * MiB, WS_END = 489 * MiB;
constexpr size_t WS_O = WS_Q;
constexpr size_t WS_G = 297 * MiB;
constexpr size_t WS_P1 = WS_K;
constexpr size_t WS_MG = WS_ADFT;
constexpr size_t WS_X1G = WS_GF;
constexpr size_t WS_U = WS_Q;
static_assert(WS_U + (size_t)M * DFF * 2 <= WS_GF, "u must not reach x1g");
constexpr size_t DO_XG = 0, DO_OPC = 0, DO_G = 96 * MiB;
constexpr int LDS_BYTES = 147456;

struct Args { const float* in[16]; float* out; unsigned char* ws; int ph_lo, ph_hi, rmask, pad; };

__device__ __forceinline__ unsigned f2bf(float f) { unsigned u = __builtin_bit_cast(unsigned, f); return (u + 0x7fffu + ((u >> 16) & 1u)) >> 16; }
__device__ __forceinline__ unsigned pk2(float lo, float hi) { return f2bf(lo) | (f2bf(hi) << 16); }
__device__ __forceinline__ float wave_sum(float v) {
#pragma unroll
    for (int o = 1; o < 64; o <<= 1) v += __shfl_xor(v, o);
    return v;
}
static __device__ const double INVF[16] = {1.0, 0.44036660267178046, 0.19392274474868576, 0.08539710028576561, 0.03760603093086393, 0.016560440080994446, 0.007292664737217109,
    0.003211445994752591, 0.001414213562373095, 0.000622772421914596, 0.0002742481756762073, 0.00012076973741146504, 5.318295896944988e-05, 2.341999896140934e-05,
    1.031338537721246e-05, 4.5416704806078695e-06};

__device__ __forceinline__ void tr_item(const float* cp, int dl4, size_t ld, int K, bf16* WTblk  , LAS float* scr, int lane) {
    f32x4 v[8];
#pragma unroll
    for (int i = 0; i < 8; ++i) v[i] = *(const f32x4*)(cp + (size_t)(8 * i) * ld);
    LAS float* d = scr + (lane >> 3) * 33 + dl4;
#pragma unroll
    for (int i = 0; i < 8; ++i) { d[(8 * i) * 33 + 0] = v[i].x; d[(8 * i) * 33 + 1] = v[i].y; d[(8 * i) * 33 + 2] = v[i].z; d[(8 * i) * 33 + 3] = v[i].w; }
    LDS_WAIT(); asm volatile("" ::: "memory");
    const int c = lane & 7;
#pragma unroll
    for (int j = 0; j < 4; ++j) { const int n = (lane >> 3) + 8 * j; const LAS float* s = scr + (8 * c) * 33 + n;
        v4u o; o.x = pk2(s[0 * 33], s[1 * 33]); o.y = pk2(s[2 * 33], s[3 * 33]); o.z = pk2(s[4 * 33], s[5 * 33]); o.w = pk2(s[6 * 33], s[7 * 33]);
        *(v4u*)(WTblk + (size_t)n * K + 8 * c) = o; }
    LDS_WAIT(); asm volatile("" ::: "memory");
}

#define XB_TMO      128
#define XB_XCNT(j)  (256  + 64 * (j))
#define XB_XSUB(j)  (1280 + 64 * (j))
#define XB_XGEN(j)  (2304 + 64 * (j))
#define XB_TOP      3328
#define XB_TOPGEN   3392
#define XCD_BAR_WORDS 3456
#define XB_SPIN_CAP (1u << 18)

__device__ __forceinline__ unsigned xb_ld(unsigned* p)              { return __hip_atomic_load(p, __ATOMIC_RELAXED, __HIP_MEMORY_SCOPE_AGENT); }
__device__ __forceinline__ unsigned xb_add(unsigned* p, unsigned v) { return __hip_atomic_fetch_add(p, v, __ATOMIC_RELAXED, __HIP_MEMORY_SCOPE_AGENT); }
__device__ __forceinline__ unsigned xb_xcc_id() { return (unsigned)__builtin_amdgcn_s_getreg((3 << 11) | 20) & 0xFu; }
#define XB_SPIN(cond, bar) do { unsigned _sp = 0; while (cond) { __builtin_amdgcn_s_sleep(1); \
    if ((++_sp & 255u) == 0u) { if (xb_ld(&(bar)[XB_TMO])) break; if (_sp > XB_SPIN_CAP) { atomicAdd(&(bar)[XB_TMO], 1u); break; } } } } while (0)

struct XcdBarrier {
    unsigned* bar; unsigned x;
    volatile LAS unsigned* st;
};

__device__ __forceinline__ XcdBarrier xcd_barrier_post(unsigned* bar, volatile LAS unsigned* st) {
    XcdBarrier b; b.bar = bar; b.x = xb_xcc_id(); b.st = st;
    if (threadIdx.x == 0) (void)xb_add(&bar[XB_XCNT(b.x)], 1u);
    return b;
}
__device__ __forceinline__ void xcd_barrier_complete(unsigned* bar, unsigned x, unsigned& nloc, unsigned& nx) {
    const unsigned G = gridDim.x * gridDim.y * gridDim.z;
    unsigned sum, cnt, mine, sp = 0u;
    for (;;) {
        sum = 0u; cnt = 0u; mine = 0u;
#pragma unroll
        for (unsigned j = 0; j < 16; ++j) { const unsigned c = xb_ld(&bar[XB_XCNT(j)]); sum += c; cnt += (c > 0u) ? 1u : 0u; mine = (j == x) ? c : mine; }
        if (sum == G) break;
        __builtin_amdgcn_s_sleep(1);
        if ((++sp & 255u) == 0u) { if (xb_ld(&bar[XB_TMO])) break; if (sp > XB_SPIN_CAP) { atomicAdd(&bar[XB_TMO], 1u); break; } }
    }
    nloc = mine > 0u ? mine : 1u; nx = cnt > 0u ? cnt : 1u;
}

__device__ __forceinline__ void xcd_barrier(const XcdBarrier& b) {
    asm volatile("s_waitcnt vmcnt(0)" ::: "memory");
    __syncthreads();
    if (threadIdx.x == 0) {
        unsigned* bar = b.bar;
        __builtin_amdgcn_s_waitcnt(0);
        unsigned nloc = b.st[0], nx = b.st[1];
        if (nloc == 0u) { xcd_barrier_complete(bar, b.x, nloc, nx); b.st[0] = nloc; b.st[1] = nx; }
        const unsigned old = xb_add(&bar[XB_XSUB(b.x)], 1u);
        const unsigned gen = old / nloc;
        if (old + 1u == (gen + 1u) * nloc) {
            __builtin_amdgcn_fence(__ATOMIC_RELEASE, "agent");
            asm volatile("s_waitcnt vmcnt(0)" ::: "memory");
            const unsigned og = xb_add(&bar[XB_TOP], 1u);
            const unsigned tg = og / nx;
            if (og + 1u == (tg + 1u) * nx) xb_add(&bar[XB_TOPGEN], 1u);
            else XB_SPIN(xb_ld(&bar[XB_TOPGEN]) == tg, bar);
            __builtin_amdgcn_fence(__ATOMIC_ACQUIRE, "agent");
            xb_add(&bar[XB_XGEN(b.x)], 1u);
            asm volatile("s_waitcnt vmcnt(0)" ::: "memory");
        } else {
            XB_SPIN(xb_ld(&bar[XB_XGEN(b.x)]) == gen, bar);
            __builtin_amdgcn_fence(__ATOMIC_ACQUIRE, "agent");
            asm volatile("s_waitcnt vmcnt(0)" ::: "memory");
        }
    }
    __syncthreads();
}

__global__ void __launch_bounds__(NTHREADS, 2) mk_fwd(Args args) {
    extern __shared__ __attribute__((aligned(16))) unsigned char lds[];
    cg::grid_group grid = cg::this_grid();
    const int tid = threadIdx.x, lane = tid & 63, wave = __builtin_amdgcn_readfirstlane(tid >> 6);
    const int G = gridDim.x, bx = blockIdx.x, vcu = (G % 8 == 0) ? (bx % 8) * (G / 8) + bx / 8 : bx;
    const int gw = vcu * NWAVES + wave, NGW = G * NWAVES;
    const bool hwbx_is_zero = (blockIdx.x == 0);
    volatile LAS unsigned* xbst = (volatile LAS unsigned*)((LAS unsigned char*)lds + LDS_BYTES - 16);
    if (tid == 0) { xbst[0] = 0u; xbst[1] = 0u; }
    if (hwbx_is_zero) { unsigned* bw = (unsigned*)(args.ws + WS_BAR); for (int i = tid; i < XCD_BAR_WORDS; i += NTHREADS) bw[i] = 0u; }
    __syncthreads();
    XcdBarrier xbar; xbar.bar = (unsigned*)(args.ws + WS_BAR); xbar.x = 0; xbar.st = xbst;
    const long gtid = (long)bx * NTHREADS + tid, NGT = (long)G * NTHREADS;
    unsigned char* ws = args.ws; unsigned char* dout = (unsigned char*)args.out;
    const float* x = args.in[0]; const float* g_mix = args.in[1]; const float* w_in = args.in[2];
    const float* lq1 = args.in[3]; const float* lk1 = args.in[4]; const float* lq2 = args.in[5]; const float* lk2 = args.in[6];
    const float* g_subln = args.in[7]; const float* w_attn = args.in[8]; const float* w_four = args.in[9]; const float* w_out = args.in[10];
    const float* g_ffn = args.in[11]; const float* w_gate = args.in[12]; const float* w_up = args.in[13]; const float* w_down = args.in[14]; const float* g_final = args.in[15];
    float* inv0 = (float*)(ws + WS_INV0); float* ss1 = (float*)(ws + WS_SS1); float* ss2 = (float*)(ws + WS_SS2); float* rope = (float*)(ws + WS_ROPE);
    bf16* WIN = (bf16*)(ws + WS_WIN); bf16* WA = (bf16*)(ws + WS_WA); bf16* WCS = (bf16*)(ws + WS_WCS); bf16* WOUT = (bf16*)(ws + WS_WOUT); bf16* WGU = (bf16*)(ws + WS_WGU); bf16* WDN = (bf16*)(ws + WS_WDN);
    bf16* ADFT = (bf16*)(ws + WS_ADFT);
    bf16* Qb = (bf16*)(ws + WS_Q); bf16* Kb = (bf16*)(ws + WS_K); bf16* Vb = (bf16*)(ws + WS_V); bf16* FT = (bf16*)(ws + WS_FT); bf16* Fb = (bf16*)(ws + WS_F); bf16* GAb = (bf16*)(ws + WS_GA); bf16* GFb = (bf16*)(ws + WS_GF);
    bf16* Ob = (bf16*)(ws + WS_O); bf16* P1 = (bf16*)(ws + WS_P1); bf16* MG = (bf16*)(ws + WS_MG); bf16* X1G = (bf16*)(ws + WS_X1G); bf16* Ub = (bf16*)(ws + WS_U);
    bf16* XG = (bf16*)(dout + DO_XG); bf16* OPC = (bf16*)(dout + DO_OPC);
#if defined(MK_PROBE) && MK_PROBE == 5
    bf16* Gb = (bf16*)(ws + WS_V);
#else
    bf16* Gb = (bf16*)(ws + WS_G);
#endif
    LAS unsigned char* glds = (LAS unsigned char*)lds;

    const int lo = args.ph_lo, hi = args.ph_hi, rmask = args.rmask;
#ifndef MK_PHASE_MASK
#define MK_PHASE_MASK 0x3ff
#endif
#define IN(k) ((((MK_PHASE_MASK) >> (k)) & 1) && ((rmask >> (k)) & 1) && lo <= (k) && (k) < hi)
#define SEAM(k) do { if (IN(k) && IN((k) + 1)) { if ((k) == 0) { grid.sync(); xbar = xcd_barrier_post((unsigned*)(args.ws + WS_BAR), xbst); } else xcd_barrier(xbar); } } while (0)
#ifndef MK_REPEAT
#define MK_REPEAT -1
#endif
#define REP(k) for (int rep_ = 0; rep_ < ((k) == MK_REPEAT ? 2 : 1); ++rep_)

#if defined(MK_SELFPOISON)
    { const v4u pz = {0xAAAAAAAAu, 0xAAAAAAAAu, 0xAAAAAAAAu, 0xAAAAAAAAu};
      v4u* zp = (v4u*)ws; const size_t n16 = (size_t)WS_END / 16; for (size_t i = (size_t)gtid; i < n16; i += (size_t)NGT) zp[i] = pz;
      v4u* op = (v4u*)dout; const size_t o16 = (size_t)M * DM * 4 / 16; for (size_t i = (size_t)gtid; i < o16; i += (size_t)NGT) op[i] = pz;
      grid.sync(); }
#endif
    REP(0) if (IN(0)) {
        for (long i = gtid; i < 2 * M; i += NGT) ss1[i] = 0.f;
#if defined(MK_NANFILL)
        { v4u* zp = (v4u*)(ws + WS_Q); const size_t n16 = (size_t)(WS_END - WS_Q) / 16; const v4u nanv = {0x7fc07fc0u, 0x7fc07fc0u, 0x7fc07fc0u, 0x7fc07fc0u};
          for (size_t i = (size_t)gtid; i < n16; i += (size_t)NGT) zp[i] = nanv; }
#endif
        for (int m = gw; m < M; m += NGW) {
            const GAS f32x4* xr = (const GAS f32x4*)(x + (size_t)m * DM) + lane; const f32x4* g4 = (const f32x4*)g_mix + lane;
            f32x4 v[8]; float s = 0.f;
#pragma unroll
            for (int j = 0; j < 8; ++j) { v[j] = xr[64 * j]; s += (v[j].x * v[j].x + v[j].y * v[j].y) + (v[j].z * v[j].z + v[j].w * v[j].w); }
            s = wave_sum(s);
            if (lane == 0) inv0[m] = 1.0f / sqrtf(s * (1.0f / DM) + RMS_EPS);
            v2u* o8 = (v2u*)(XG + (size_t)m * DM) + lane;
#pragma unroll
            for (int j = 0; j < 8; ++j) { const f32x4 g = g4[64 * j]; v2u w; w.x = pk2(v[j].x * g.x, v[j].y * g.y); w.y = pk2(v[j].z * g.z, v[j].w * g.w); o8[64 * j] = w; }
        }
        {
            LAS float* scr = (LAS float*)((LAS unsigned char*)lds + wave * 16384);
            constexpr int I_IN = (DM / 64) * (INW / 32), I_A = (VW / 64) * (DM / 32), I_O = (DM / 64) * (DM / 32), I_GU = (DM / 64) * (2 * DFF / 32), I_DN = (DFF / 64) * (DM / 32);
            constexpr int NITEMS = I_IN + I_A + I_O + I_GU + I_DN;
            const int q = lane & 7, q4 = q * 4, kr = lane >> 3;
            for (int it = gw; it < NITEMS; it += NGW) {
                int r = it;
                if (r < I_IN) { const int nblk = INW / 32, kb = r / nblk, nb = r % nblk; tr_item(w_in + (size_t)(64 * kb + kr) * INW + 32 * nb + q4, q4, INW, DM, WIN + (size_t)(32 * nb) * DM + 64 * kb, scr, lane); continue; } r -= I_IN;
                if (r < I_A) { const int nblk = DM / 32, kb = r / nblk, nb = r % nblk; tr_item(w_attn + (size_t)(64 * kb + kr) * DM + 32 * nb + q4, q4, DM, VW, WA + (size_t)(32 * nb) * VW + 64 * kb, scr, lane); continue; } r -= I_A;
                if (r < I_O) { const int nblk = DM / 32, kb = r / nblk, nb = r % nblk; tr_item(w_out + (size_t)(64 * kb + kr) * DM + 32 * nb + q4, q4, DM, DM, WOUT + (size_t)(32 * nb) * DM + 64 * kb, scr, lane); continue; } r -= I_O;
                if (r < I_GU) { const int nblk = 2 * DFF / 32, kb = r / nblk, nb = r % nblk;
                    const int nn = q >> 2, j = (q & 3) * 4, dl4 = 8 * (q & 3) + 4 * nn;
                    tr_item((nn ? w_up : w_gate) + (size_t)(64 * kb + kr) * DFF + 16 * nb + j, dl4, DFF, DM, WGU + (size_t)(32 * nb) * DM + 64 * kb, scr, lane); continue; } r -= I_GU;
                { const int nblk = DM / 32, kb = r / nblk, nb = r % nblk; tr_item(w_down + (size_t)(64 * kb + kr) * DM + 32 * nb + q4, q4, DM, DFF, WDN + (size_t)(32 * nb) * DFF + 64 * kb, scr, lane); }
            }
        }
        for (long t = gtid; t < (long)4096 * 256; t += NGT) {
            const int m = (int)(t >> 8), s0 = (int)(t & 255) * 8, part = m >> 11, k = 2 * (m & 1023) + ((m >> 10) & 1); float v[8];
#pragma unroll
            for (int e = 0; e < 8; ++e) { const float ph = (float)((k * (s0 + e)) & 4095) * (1.0f / 4096.0f); v[e] = part ? __builtin_amdgcn_sinf(ph) : __builtin_amdgcn_cosf(ph); }
            v4u o; o.x = pk2(v[0], v[1]); o.y = pk2(v[2], v[3]); o.z = pk2(v[4], v[5]); o.w = pk2(v[6], v[7]);
            *(v4u*)(ADFT + (size_t)m * 2048 + s0) = o;
        }
        for (long t = gtid; t < 4096 * 16; t += NGT) {
            const int pos = (int)(t >> 4), j = (int)(t & 15);
            double rev = (double)pos * INVF[j] * 0.15915494309189535; rev -= floor(rev);
            const float r = (float)rev; rope[2 * t] = __builtin_amdgcn_cosf(r); rope[2 * t + 1] = __builtin_amdgcn_sinf(r);
        }
    }
    SEAM(0);

    REP(1) if (IN(1)) {
        pg8::Gemm g{XG, WIN, M, INW, DM}; pg8::StaticOrder S; S.init(M, INW, G, bx);
        pg8::EpiZ E{Qb, Kb, Vb, Fb, GAb, GFb, inv0, rope};
        pg8::gemm_phase<pg8::EpiZ, pg8::StaticOrder, true, true>(glds, g, S, E);
    }
    SEAM(1);

    REP(2) if (IN(2)) {
        {
            LAS unsigned short* t16 = (LAS unsigned short*)((LAS unsigned char*)lds + wave * 16384);
            for (int t = gw; t < 2048; t += NGW) {
                const int par = t & 1, tt = t >> 1, sbp = tt >> 3, nb = tt & 7, b = sbp >> 5, s0 = (sbp & 31) * 64, r0 = b * 4096 + s0;
                const float sg = par ? -1.0f : 1.0f;
#pragma unroll
                for (int i = 0; i < 8; ++i) { const int row = (lane >> 3) + 8 * i, ch = lane & 7;
                    const v4u lo4 = *(const v4u*)(Fb + (size_t)(r0 + row) * 512 + nb * 64 + ch * 8), hi4 = *(const v4u*)(Fb + (size_t)(r0 + 2048 + row) * 512 + nb * 64 + ch * 8);
                    v4u v;
#define ED(C) v.C = pk2(pg8::bflo(lo4.C) + sg * pg8::bflo(hi4.C), pg8::bfhi(lo4.C) + sg * pg8::bfhi(hi4.C))
                    ED(x); ED(y); ED(z); ED(w);
#undef ED
                    LAS unsigned short* d = t16 + (ch * 8) * 66 + row;
                    d[0 * 66] = (unsigned short)(v.x & 0xffffu); d[1 * 66] = (unsigned short)(v.x >> 16); d[2 * 66] = (unsigned short)(v.y & 0xffffu); d[3 * 66] = (unsigned short)(v.y >> 16);
                    d[4 * 66] = (unsigned short)(v.z & 0xffffu); d[5 * 66] = (unsigned short)(v.z >> 16); d[6 * 66] = (unsigned short)(v.w & 0xffffu); d[7 * 66] = (unsigned short)(v.w >> 16); }
                LDS_WAIT(); asm volatile("" ::: "memory");
                const LAS unsigned* rp = (const LAS unsigned*)(t16 + lane * 66);
                bf16* orow = FT + ((size_t)(par * 2048 + b * 512 + nb * 64 + lane)) * 2048 + s0;
#pragma unroll
                for (int j = 0; j < 8; ++j) { v4u o; o.x = rp[4 * j]; o.y = rp[4 * j + 1]; o.z = rp[4 * j + 2]; o.w = rp[4 * j + 3]; *(v4u*)(orow + 8 * j) = o; }
                LDS_WAIT(); asm volatile("" ::: "memory");
            }
            __syncthreads();
        }
        for (int i = 0;; ++i) {
            const int u = i * G + vcu; if (u >= 1536) break;
            const int qb = u & 31, grp = u >> 5, c = grp & 1, h = (grp >> 1) % NH, b = grp / (2 * NH);
            const att::bf16* Qp = (const att::bf16*)Qb + ((size_t)b * SEQ + qb * 128) * QKW + (h * 2 + c) * 128;
            const att::bf16* Kp = (const att::bf16*)Kb + ((size_t)b * SEQ) * QKW + (h * 2 + c) * 128;
            const att::bf16* Vp = (const att::bf16*)Vb + ((size_t)b * SEQ) * VW + h * 256;
            att::bf16* Op = (att::bf16*)OPC + ((size_t)b * SEQ + qb * 128) * 3072 + (h * 2 + c) * 256;
            att::attn_pc_unit(Qp, Kp, Vp, Op, (char*)lds, (2 * qb) & 63);
        }
    }
    SEAM(2);

    REP(3) if (IN(3)) {
        const int Gd = G / 2;
        constexpr int R1 = 13312;
        int c_start, c_end, c_stride;
        if (bx < Gd) {
            pg8::Gemm g{ADFT, FT, 4096, 4096, 2048}; pg8::DftOrder S; S.S0.init(4096, 2048, Gd, bx);
            pg8::EpiDft E{Gb};
            pg8::gemm_phase<pg8::EpiDft, pg8::DftOrder, true, true>(glds, g, S, E);
            c_start = R1 + bx * NWAVES + wave; c_end = M; c_stride = Gd * NWAVES;
        } else {
            const int gw2 = (bx - Gd) * NWAVES + wave, NGW2 = (G - Gd) * NWAVES;
            for (int n = gw2; n < 2048; n += NGW2) {
                const bf16* fr_ = FT + (size_t)n * 2048; float a = 0.f;
#pragma unroll
                for (int j = 0; j < 4; ++j) { const v4u w = *((const v4u*)(fr_ + j * 512) + lane);
                    a += (pg8::bflo(w.x) - pg8::bfhi(w.x)) + (pg8::bflo(w.y) - pg8::bfhi(w.y)) + (pg8::bflo(w.z) - pg8::bfhi(w.z)) + (pg8::bflo(w.w) - pg8::bfhi(w.w)); }
                a = wave_sum(a);
                if (lane == 0) { bf16* gp = Gb + ((size_t)(n >> 9) * 4096 + 2048) * 1024 + (n & 511); gp[0] = (bf16)f2bf(a); gp[512] = 0; }
            }
            for (int t = gw2; t < 1024; t += NGW2) {
                const int nchunk = t & 7, dblk = (t >> 3) & 15, g = (t >> 7) & 3, part = t >> 9, n = nchunk * 256 + lane * 4;
                f32x4 a[8];
    #pragma unroll
                for (int dd = 0; dd < 8; ++dd) a[dd] = (f32x4){0.f, 0.f, 0.f, 0.f};
                const float* wp = w_four + (size_t)(g * 128) * DM + n;
    #pragma unroll 2
                for (int c = 0; c < 128; ++c) { const f32x4 w = *(const f32x4*)(wp + (size_t)c * DM);
    #pragma unroll
                    for (int dd = 0; dd < 8; ++dd) { const float ph = (float)(((dblk * 8 + dd) * c) & 127) * (1.0f / 128.0f);
                        const float tv = part ? __builtin_amdgcn_sinf(ph) : __builtin_amdgcn_cosf(ph); a[dd] += w * tv; } }
                const float sc = (part ? -1.0f : 1.0f) * 0.0013810679320049755f;
    #pragma unroll
                for (int q = 0; q < 4; ++q) { v4u o; o.x = pk2(a[0][q] * sc, a[1][q] * sc); o.y = pk2(a[2][q] * sc, a[3][q] * sc); o.z = pk2(a[4][q] * sc, a[5][q] * sc); o.w = pk2(a[6][q] * sc, a[7][q] * sc);
                    *(v4u*)(WCS + (size_t)(n + q) * 1024 + part * 512 + g * 128 + dblk * 8) = o; }
            }
            c_start = gw2; c_end = R1; c_stride = NGW2;
        }
        float lam;
        { const float a1 = lq1[lane] * lk1[lane] + lq1[lane + 64] * lk1[lane + 64], a2 = lq2[lane] * lk2[lane] + lq2[lane + 64] * lk2[lane + 64];
          lam = expf(wave_sum(a1)) - expf(wave_sum(a2)) + LAMBDA_INIT; }
        const f32x4 gs = *((const f32x4*)g_subln + lane);
        for (int row = c_start; row < c_end; row += c_stride) {
            v2u a[NH], b2[NH];
#pragma unroll
            for (int h = 0; h < NH; ++h) { a[h] = *((const v2u*)(OPC + (size_t)row * 3072 + (2 * h) * 256) + lane); b2[h] = *((const v2u*)(OPC + (size_t)row * 3072 + (2 * h + 1) * 256) + lane); }
#pragma unroll
            for (int h = 0; h < NH; ++h) {
                f32x4 d; d.x = pg8::bflo(a[h].x) - lam * pg8::bflo(b2[h].x); d.y = pg8::bfhi(a[h].x) - lam * pg8::bfhi(b2[h].x); d.z = pg8::bflo(a[h].y) - lam * pg8::bflo(b2[h].y); d.w = pg8::bfhi(a[h].y) - lam * pg8::bfhi(b2[h].y);
                const float ss = wave_sum((d.x * d.x + d.y * d.y) + (d.z * d.z + d.w * d.w));
                const float sc = (1.0f - LAMBDA_INIT) / sqrtf(ss * (1.0f / 256.0f) + RMS_EPS);
                v2u w; w.x = pk2(d.x * sc * gs.x, d.y * sc * gs.y); w.y = pk2(d.z * sc * gs.z, d.w * sc * gs.w);
                *((v2u*)(Ob + (size_t)row * VW + h * 256) + lane) = w;
            }
        }
    }
    SEAM(3);

    REP(4) if (IN(4)) {
        pg8::Gemm g{Ob, WA, M, DM, VW}; pg8::StaticOrder S; S.init(M, DM, G, bx);
        pg8::EpiGateA E{GAb, P1};
        pg8::gemm_phase<pg8::EpiGateA, pg8::StaticOrder, true, true>(glds, g, S, E);
    }
    REP(5) if (IN(5)) {
        pg8::Gemm g{Gb, WCS, M, DM, 1024}; pg8::StaticOrder S; S.init(M, DM, G, bx);
        pg8::EpiGateF E{GFb, P1, MG};
        pg8::gemm_phase<pg8::EpiGateF, pg8::StaticOrder, true, true>(glds, g, S, E);
    }
    SEAM(5);

    REP(6) if (IN(6)) {
        pg8::Gemm g{MG, WOUT, M, DM, DM}; pg8::StaticOrder S; S.init(M, DM, G, bx);
        pg8::EpiRes<true> E{x, args.out, X1G, g_ffn, ss1};
        pg8::gemm_phase<pg8::EpiRes<true>, pg8::StaticOrder, true, true>(glds, g, S, E);
    }
    SEAM(6);

    REP(7) if (IN(7)) {
        pg8::Gemm g{X1G, WGU, M, 2 * DFF, DM}; pg8::StaticOrder S; S.init(M, 2 * DFF, G, bx);
        pg8::EpiSwiGLU E{Ub, ss1};
        pg8::gemm_phase<pg8::EpiSwiGLU, pg8::StaticOrder, true, true>(glds, g, S, E);
    }
    SEAM(7);

    REP(8) if (IN(8)) {
        pg8::Gemm g{Ub, WDN, M, DM, DFF}; pg8::StaticOrder S; S.init(M, DM, G, bx);
        pg8::EpiRes<false> E{args.out, args.out, nullptr, nullptr, ss2};
        pg8::gemm_phase<pg8::EpiRes<false>, pg8::StaticOrder, true, true>(glds, g, S, E);
    }
    SEAM(8);

    REP(9) if (IN(9)) {
        for (int m = gw; m < M; m += NGW) {
            const float rs = 1.0f / sqrtf(ss2[m] * (1.0f / DM) + RMS_EPS);
            f32x4* xr = (f32x4*)(args.out + (size_t)m * DM) + lane; const f32x4* g4 = (const f32x4*)g_final + lane;
#pragma unroll
            for (int j = 0; j < 8; ++j) xr[64 * j] = xr[64 * j] * rs * g4[64 * j];
        }
    }
#undef IN
#undef SEAM
}

#if defined(MK_PROBE)
__global__ void __launch_bounds__(256) probe_kernel(float* out, const unsigned char* ws) {
    const bf16* Ob = (const bf16*)(ws + WS_O); const bf16* MG = (const bf16*)(ws + WS_MG); const bf16* GFb = (const bf16*)(ws + WS_GF); const bf16* X1G = (const bf16*)(ws + WS_X1G);
    for (size_t i = (size_t)blockIdx.x * 256 + threadIdx.x; i < (size_t)M * DM; i += (size_t)gridDim.x * 256) {
        const size_t m = i / DM; const int c = (int)(i % DM); float v = 0.f;
#if MK_PROBE == 1
        if (c < 1536) v = __uint_as_float((unsigned)Ob[m * 1536 + c] << 16);
#elif MK_PROBE == 2
        v = __uint_as_float((unsigned)MG[m * 2048 + c] << 16);
#elif MK_PROBE == 3
        v = __uint_as_float((unsigned)GFb[m * 2048 + c] << 16);
#elif MK_PROBE == 6
        v = __uint_as_float((unsigned)((const bf16*)(ws + WS_P1))[m * 2048 + c] << 16);
#elif MK_PROBE == 5
        if (c < 1024) v = __uint_as_float((unsigned)((const bf16*)(ws + WS_V))[m * 1024 + c] << 16);
#elif MK_PROBE == 7
        { const bf16* FTp = (const bf16*)(ws + WS_FT); const size_t j = (size_t)i % ((size_t)2048 * 4096); v = __uint_as_float((unsigned)FTp[j] << 16); }
#elif MK_PROBE == 8
        if (c < 1024) v = __uint_as_float((unsigned)GFb[m * 2048 + c] << 16); else if (m < 2048) v = 1000.f * __uint_as_float((unsigned)((const bf16*)(ws + WS_WCS))[m * 1024 + (c - 1024)] << 16);
#elif MK_PROBE == 9
        v = __uint_as_float((unsigned)((const bf16*)(ws + WS_GA))[m * 2048 + c] << 16);
#elif MK_PROBE == 4
        v = __uint_as_float((unsigned)X1G[m * 2048 + c] << 16);
#endif
        out[i] = v; }
}
#endif
extern "C" void kernel_launch(void* const* d_in, const int* in_sizes, int n_in, void* d_out, int out_size, void* d_ws, size_t ws_size, hipStream_t stream) {
    static int grid = 0;
    if (grid == 0) {
        if (n_in != 16 || in_sizes[0] != M * DM || out_size != M * DM || ws_size < WS_END) {
            fprintf(stderr, "kernel_launch: unexpected shapes: n_in %d in0 %d out %d ws %zu (need >= %zu)\n", n_in, n_in > 0 ? in_sizes[0] : -1, out_size, ws_size, (size_t)WS_END); grid = -1; return; }
        int dev = 0, cus = 0, per_cu = 0;
        if (hipGetDevice(&dev) != hipSuccess || hipDeviceGetAttribute(&cus, hipDeviceAttributeMultiprocessorCount, dev) != hipSuccess) { grid = -1; return; }
        if (hipFuncSetAttribute((const void*)mk_fwd, hipFuncAttributeMaxDynamicSharedMemorySize, LDS_BYTES) != hipSuccess) { fprintf(stderr, "kernel_launch: hipFuncSetAttribute failed\n"); grid = -1; return; }
        if (hipOccupancyMaxActiveBlocksPerMultiprocessor(&per_cu, (const void*)mk_fwd, NTHREADS, LDS_BYTES) != hipSuccess || per_cu < 1) { fprintf(stderr, "kernel_launch: occupancy query says %d\n", per_cu); (void)hipGetLastError(); per_cu = 1; }
        grid = cus * per_cu;
    }
    if (grid < 0) return;
    Args a{};
    for (int i = 0; i < 16; ++i) a.in[i] = (const float*)d_in[i];
    a.out = (float*)d_out; a.ws = (unsigned char*)d_ws;
#ifndef MK_RMASK
#define MK_RMASK 0x3ff
#endif
    a.rmask = MK_RMASK;
#if MK_PER_PHASE
    for (int ph = 0; ph < NPHASES; ++ph) { a.ph_lo = ph; a.ph_hi = ph + 1; hipLaunchKernelGGL(mk_fwd, dim3(grid), dim3(NTHREADS), LDS_BYTES, stream, a); }
#if defined(MK_PROBE)
    hipLaunchKernelGGL(probe_kernel, dim3(2048), dim3(256), 0, stream, (float*)d_out, (const unsigned char*)d_ws);
#endif
#else
    a.ph_lo = 0; a.ph_hi = NPHASES;
    void* kargs[] = {(void*)&a};
    hipError_t e = hipLaunchCooperativeKernel((const void*)mk_fwd, dim3(grid), dim3(NTHREADS), kargs, LDS_BYTES, stream);
    if (e != hipSuccess) fprintf(stderr, "kernel_launch: cooperative launch failed: %s (grid %d)\n", hipGetErrorString(e), grid);
#endif
}
```

```cpp
#include <hip/hip_runtime.h>
#include <hip/hip_bf16.h>
#include <hip/hip_cooperative_groups.h>
#include <cstdio>
#include <cstdint>
#include <cmath>
namespace cg = cooperative_groups;
namespace pg8 {
#define PG8_LAS __attribute__((address_space(3)))
typedef unsigned short bf16_t;
typedef short bf16x8 __attribute__((ext_vector_type(8)));
typedef float f32x4 __attribute__((ext_vector_type(4)));
typedef unsigned u32x4 __attribute__((ext_vector_type(4)));
constexpr int BM = 256, BK = 64, HALF = 128, HTB = HALF * BK * 2  , STAGE_BYTES = 8 * HTB, NXCD = 8, WGM = 8;

__host__ __device__ __forceinline__ int lds_byte(int r, int c) { const int st = (r >> 4) * 2 + (c >> 5), rr = r & 15, cc = c & 31, ob = rr * 64 + cc * 2; return st * 1024 + (ob ^ (((ob >> 9) & 1) << 5)); }
__host__ __device__ __forceinline__ void stage_rc(int b, int& R, int& C) { const int st = b / 1024, sb = b % 1024, swz = sb ^ (((sb >> 9) & 1) << 5); R = (st >> 1) * 16 + swz / 64; C = (st & 1) * 32 + (swz % 64) / 2; }
__host__ __device__ __forceinline__ int perm32(int rho) { const int n = rho >> 4, i = rho & 15; return 8 * (i >> 2) + 4 * n + (i & 3); }

struct Unit { int pm, pn; };
struct Gemm { const bf16_t* A; const bf16_t* Bt; int M, N, K; };

struct StaticOrder {
    int nM, nN, nwg, G, c;
    __host__ __device__ void init(int M, int N, int G_, int c_) { nM = M / BM; nN = N / BM; nwg = nM * nN; G = G_; c = c_; }
    __host__ __device__ bool next(int i, Unit& u) const {
        const long L = (long)i * G + c; if (L >= nwg) return false;
        int wgid = (int)L; { const int q = nwg / NXCD, r = nwg % NXCD, xcd = wgid % NXCD, off = wgid / NXCD; wgid = (xcd < r ? xcd * (q + 1) : r * (q + 1) + (xcd - r) * q) + off; }
        const int nig = WGM * nN, gid = wgid / nig, fm = gid * WGM, gsz = (nM - fm) < WGM ? (nM - fm) : WGM;
        u.pm = fm + ((wgid % nig) % gsz); u.pn = (wgid % nig) / gsz; return true;
    }
    __device__ __forceinline__ void a_ready(const Unit&) const {}
    __device__ __forceinline__ void done(const Unit&) const {}
};
typedef float cvt_f32x2_t __attribute__((ext_vector_type(2))); typedef __bf16 cvt_bf16x2_t __attribute__((ext_vector_type(2)));
__device__ __forceinline__ unsigned cvt_pk_bf16(float lo, float hi) { cvt_f32x2_t v = {lo, hi}; cvt_bf16x2_t b = __builtin_convertvector(v, cvt_bf16x2_t); return __builtin_bit_cast(unsigned, b); }
typedef float f32x2 __attribute__((ext_vector_type(2)));
typedef unsigned u32x2 __attribute__((ext_vector_type(2)));
__device__ __forceinline__ float bflo(unsigned w) { return __uint_as_float(w << 16); }
__device__ __forceinline__ float bfhi(unsigned w) { return __uint_as_float(w & 0xffff0000u); }
__device__ __forceinline__ float sigmoidf_fast(float v) { return __builtin_amdgcn_rcpf(1.0f + __builtin_amdgcn_exp2f(-1.4426950408889634f * v)); }
__device__ __forceinline__ u32x4 pack8(const f32x4 v0, const f32x4 v1) { u32x4 w; w.x = cvt_pk_bf16(v0[0], v0[1]); w.y = cvt_pk_bf16(v0[2], v0[3]); w.z = cvt_pk_bf16(v1[0], v1[1]); w.w = cvt_pk_bf16(v1[2], v1[3]); return w; }

struct EpiZ {
    static constexpr bool PERM = true, AFTER_DRAIN = false;
    bf16_t *Q, *K, *V, *FT, *GA, *GF; const float* inv_rms; const float* rope;
    __device__ __forceinline__ void operator()(const f32x4 (&acc)[2][2][4][2], const Unit& u, int wr, int wc, int fr, int fq) const {
        const int pn = u.pn, row0 = u.pm * BM + wr * 64 + fr, cl0 = wc * 32 + 8 * fq;
        if (pn < 12) {
            bf16_t* base = (pn < 6 ? Q : K) + (pn % 6) * 256 + cl0;
#pragma unroll
            for (int ai = 0; ai < 2; ++ai)
#pragma unroll
                for (int m = 0; m < 4; ++m) {
                    const int row = row0 + ai * HALF + m * 16; const float rs = inv_rms[row];
                    f32x4 cs[4];
                    if (wc == 0) { const f32x4* rp = (const f32x4*)(rope + (size_t)(row & 4095) * 32 + (fq & 1) * 16);
#pragma unroll
                        for (int t = 0; t < 4; ++t) cs[t] = rp[t]; }
#pragma unroll
                    for (int bj = 0; bj < 2; ++bj) {
                        f32x4 v0 = acc[ai][bj][m][0] * rs, v1 = acc[ai][bj][m][1] * rs;
                        if (wc == 0) {
                            const float sg = (fq < 2) ? -1.f : 1.f;
#pragma unroll
                            for (int i = 0; i < 4; ++i) {
                                const float p0 = __shfl_xor(v0[i], 32), p1 = __shfl_xor(v1[i], 32);
                                const float c0 = cs[i >> 1][(i & 1) * 2], s0 = cs[i >> 1][(i & 1) * 2 + 1];
                                const float c1 = cs[2 + (i >> 1)][(i & 1) * 2], s1 = cs[2 + (i >> 1)][(i & 1) * 2 + 1];
                                v0[i] = v0[i] * c0 + sg * p0 * s0; v1[i] = v1[i] * c1 + sg * p1 * s1;
                            }
                        }
                        *(u32x4*)(base + (size_t)row * 1536 + bj * HALF) = pack8(v0, v1);
                    }
                }
        } else if (pn < 18) {
            bf16_t* base = V + (pn - 12) * 256 + cl0;
#pragma unroll
            for (int ai = 0; ai < 2; ++ai)
#pragma unroll
                for (int m = 0; m < 4; ++m) { const int row = row0 + ai * HALF + m * 16; const float rs = inv_rms[row];
#pragma unroll
                    for (int bj = 0; bj < 2; ++bj) *(u32x4*)(base + (size_t)row * 1536 + bj * HALF) = pack8(acc[ai][bj][m][0] * rs, acc[ai][bj][m][1] * rs); }
        } else if (pn < 20) {
            bf16_t* base = FT + (pn - 18) * 256 + cl0;
#pragma unroll
            for (int ai = 0; ai < 2; ++ai)
#pragma unroll
                for (int m = 0; m < 4; ++m) { const int row = row0 + ai * HALF + m * 16; const float rs = inv_rms[row];
#pragma unroll
                    for (int bj = 0; bj < 2; ++bj) *(u32x4*)(base + (size_t)row * 512 + bj * HALF) = pack8(acc[ai][bj][m][0] * rs, acc[ai][bj][m][1] * rs); }
        } else {
            bf16_t* base = (pn < 28 ? GA + (pn - 20) * 256 : GF + (pn - 28) * 256) + cl0;
#pragma unroll
            for (int ai = 0; ai < 2; ++ai)
#pragma unroll
                for (int m = 0; m < 4; ++m) { const int row = row0 + ai * HALF + m * 16; const float rs = inv_rms[row];
#pragma unroll
                    for (int bj = 0; bj < 2; ++bj) { f32x4 v0 = acc[ai][bj][m][0] * rs, v1 = acc[ai][bj][m][1] * rs;
#pragma unroll
                        for (int i = 0; i < 4; ++i) { v0[i] = sigmoidf_fast(v0[i]); v1[i] = sigmoidf_fast(v1[i]); }
                        *(u32x4*)(base + (size_t)row * 2048 + bj * HALF) = pack8(v0, v1); } }
        }
    }
};

struct EpiDft {
    static constexpr bool PERM = true, AFTER_DRAIN = false;
    bf16_t* G;
    __device__ __forceinline__ void operator()(const f32x4 (&acc)[2][2][4][2], const Unit& u, int wr, int wc, int fr, int fq) const {
        const int part = u.pm >> 3, parity = (u.pm >> 2) & 1, kk0 = (u.pm & 3) * BM + wr * 64 + fr, pn = u.pn & 7, b = pn >> 1, col0 = part * 512 + (pn & 1) * 256 + wc * 32 + 8 * fq;
        const unsigned sgn = part ? 0x80008000u : 0u;
#pragma unroll
        for (int ai = 0; ai < 2; ++ai)
#pragma unroll
            for (int m = 0; m < 4; ++m) { const int k = 2 * (kk0 + ai * HALF + m * 16) + parity; const size_t row = (size_t)b * 4096 + k, rowm = (size_t)b * 4096 + (4096 - k);
#pragma unroll
                for (int bj = 0; bj < 2; ++bj) { const u32x4 w = pack8(acc[ai][bj][m][0], acc[ai][bj][m][1]);
                    *(u32x4*)(G + row * 1024 + col0 + bj * HALF) = w;
                    if (k > 0) { u32x4 wm; wm.x = w.x ^ sgn; wm.y = w.y ^ sgn; wm.z = w.z ^ sgn; wm.w = w.w ^ sgn; *(u32x4*)(G + rowm * 1024 + col0 + bj * HALF) = wm; } } }
    }
};
struct DftOrder {
    StaticOrder S0;
    __device__ __forceinline__ bool next(int i, Unit& u) const { if (!S0.next(i, u)) return false; u.pn += 8 * ((u.pm >> 2) & 1); return true; }
    __device__ __forceinline__ void a_ready(const Unit&) const {}
    __device__ __forceinline__ void done(const Unit&) const {}
};

struct EpiGateA {
    static constexpr bool PERM = true, AFTER_DRAIN = false;
    const bf16_t* GA; bf16_t* P1;
    __device__ __forceinline__ void operator()(const f32x4 (&acc)[2][2][4][2], const Unit& u, int wr, int wc, int fr, int fq) const {
        const int row0 = u.pm * BM + wr * 64 + fr, col0 = u.pn * BM + wc * 32 + 8 * fq;
#pragma unroll
        for (int ai = 0; ai < 2; ++ai)
#pragma unroll
            for (int m = 0; m < 4; ++m)
#pragma unroll
                for (int bj = 0; bj < 2; ++bj) { const size_t off = (size_t)(row0 + ai * HALF + m * 16) * 2048 + col0 + bj * HALF;
                    const u32x4 g = *(const u32x4*)(GA + off); const f32x4 a0 = acc[ai][bj][m][0], a1 = acc[ai][bj][m][1]; u32x4 w;
                    w.x = cvt_pk_bf16(a0[0] * bflo(g.x), a0[1] * bfhi(g.x)); w.y = cvt_pk_bf16(a0[2] * bflo(g.y), a0[3] * bfhi(g.y));
                    w.z = cvt_pk_bf16(a1[0] * bflo(g.z), a1[1] * bfhi(g.z)); w.w = cvt_pk_bf16(a1[2] * bflo(g.w), a1[3] * bfhi(g.w));
                    *(u32x4*)(P1 + off) = w; }
    }
};
struct EpiGateF {
    static constexpr bool PERM = true, AFTER_DRAIN = false;
    const bf16_t* GF; const bf16_t* P1; bf16_t* MG;
    __device__ __forceinline__ void operator()(const f32x4 (&acc)[2][2][4][2], const Unit& u, int wr, int wc, int fr, int fq) const {
        const int row0 = u.pm * BM + wr * 64 + fr, col0 = u.pn * BM + wc * 32 + 8 * fq;
#pragma unroll
        for (int ai = 0; ai < 2; ++ai)
#pragma unroll
            for (int m = 0; m < 4; ++m)
#pragma unroll
                for (int bj = 0; bj < 2; ++bj) { const size_t off = (size_t)(row0 + ai * HALF + m * 16) * 2048 + col0 + bj * HALF;
                    const u32x4 g = *(const u32x4*)(GF + off); const u32x4 p = *(const u32x4*)(P1 + off); const f32x4 a0 = acc[ai][bj][m][0], a1 = acc[ai][bj][m][1]; u32x4 w;
                    w.x = cvt_pk_bf16(bflo(p.x) + a0[0] * bflo(g.x), bfhi(p.x) + a0[1] * bfhi(g.x)); w.y = cvt_pk_bf16(bflo(p.y) + a0[2] * bflo(g.y), bfhi(p.y) + a0[3] * bfhi(g.y));
                    w.z = cvt_pk_bf16(bflo(p.z) + a1[0] * bflo(g.z), bfhi(p.z) + a1[1] * bfhi(g.z)); w.w = cvt_pk_bf16(bflo(p.w) + a1[2] * bflo(g.w), bfhi(p.w) + a1[3] * bfhi(g.w));
                    *(u32x4*)(MG + off) = w; }
    }
};
template <bool WITH_XG> struct EpiRes {
    static constexpr bool PERM = false, AFTER_DRAIN = false;
    const float* base; float* out; bf16_t* xg; const float* gvec; float* rowss;
    __device__ __forceinline__ void operator()(const f32x4 (&acc)[2][2][4][2], const Unit& u, int wr, int wc, int fr, int fq) const {
        const int row0 = u.pm * BM + wr * 64 + fr, col0 = u.pn * BM + wc * 32 + 4 * fq;
        f32x4 gv[2][2];
        if (WITH_XG) {
#pragma unroll
            for (int bj = 0; bj < 2; ++bj)
#pragma unroll
                for (int n = 0; n < 2; ++n) gv[bj][n] = *(const f32x4*)(gvec + col0 + bj * HALF + n * 16); }
#pragma unroll
        for (int ai = 0; ai < 2; ++ai)
#pragma unroll
            for (int m = 0; m < 4; ++m) { const int row = row0 + ai * HALF + m * 16; const size_t off = (size_t)row * 2048 + col0; float ss = 0.f;
#pragma unroll
                for (int bj = 0; bj < 2; ++bj)
#pragma unroll
                    for (int n = 0; n < 2; ++n) { const f32x4 v = *(const f32x4*)(base + off + bj * HALF + n * 16) + acc[ai][bj][m][n];
                        if (!WITH_XG) *(f32x4*)(out + off + bj * HALF + n * 16) = v;
                        ss += (v[0] * v[0] + v[1] * v[1]) + (v[2] * v[2] + v[3] * v[3]);
                        if (WITH_XG) { const f32x4 t = v * gv[bj][n]; u32x2 w; w.x = cvt_pk_bf16(t[0], t[1]); w.y = cvt_pk_bf16(t[2], t[3]); *(u32x2*)(xg + off + bj * HALF + n * 16) = w; } }
                ss += __shfl_xor(ss, 16); ss += __shfl_xor(ss, 32);
                if (fq == 0) atomicAdd(rowss + row, ss); }
    }
};
struct EpiRes2 {
    static constexpr bool PERM = false, AFTER_DRAIN = false;
    bf16_t* xg; const float* gvec; float* rowss;
    __device__ __forceinline__ void operator()(const f32x4 (&acc)[2][2][4][2], const Unit& u, int wr, int wc, int fr, int fq) const {
        const int row0 = u.pm * BM + wr * 64 + fr, col0 = u.pn * BM + wc * 32 + 4 * fq;
        f32x4 rg[2][2];
#pragma unroll
        for (int bj = 0; bj < 2; ++bj)
#pragma unroll
            for (int n = 0; n < 2; ++n) { const f32x4 g = *(const f32x4*)(gvec + col0 + bj * HALF + n * 16);
                rg[bj][n] = (f32x4){__builtin_amdgcn_rcpf(g[0]), __builtin_amdgcn_rcpf(g[1]), __builtin_amdgcn_rcpf(g[2]), __builtin_amdgcn_rcpf(g[3])}; }
#pragma unroll
        for (int ai = 0; ai < 2; ++ai)
#pragma unroll
            for (int m = 0; m < 4; ++m) { const int row = row0 + ai * HALF + m * 16; const size_t off = (size_t)row * 2048 + col0; float ss = 0.f;
#pragma unroll
                for (int bj = 0; bj < 2; ++bj)
#pragma unroll
                    for (int n = 0; n < 2; ++n) { const u32x2 q = *(const u32x2*)(xg + off + bj * HALF + n * 16);
                        const f32x4 x1 = (f32x4){bflo(q.x), bfhi(q.x), bflo(q.y), bfhi(q.y)} * rg[bj][n];
                        const f32x4 v = x1 + acc[ai][bj][m][n];
                        ss += (v[0] * v[0] + v[1] * v[1]) + (v[2] * v[2] + v[3] * v[3]);
                        u32x2 w; w.x = cvt_pk_bf16(v[0], v[1]); w.y = cvt_pk_bf16(v[2], v[3]); *(u32x2*)(xg + off + bj * HALF + n * 16) = w; }
                ss += __shfl_xor(ss, 16); ss += __shfl_xor(ss, 32);
                if (fq == 0) atomicAdd(rowss + row, ss); }
    }
};
struct EpiSwiGLU {
    static constexpr bool PERM = true, AFTER_DRAIN = false;
    bf16_t* U; const float* rowss;
    __device__ __forceinline__ void operator()(const f32x4 (&acc)[2][2][4][2], const Unit& u, int wr, int wc, int fr, int fq) const {
        const int row0 = u.pm * BM + wr * 64 + fr, ucol0 = u.pn * 128 + wc * 16 + 4 * fq;
#pragma unroll
        for (int ai = 0; ai < 2; ++ai)
#pragma unroll
            for (int m = 0; m < 4; ++m) { const int row = row0 + ai * HALF + m * 16; const float rs = __builtin_amdgcn_rsqf(rowss[row] * (1.0f / 2048.0f) + 1e-5f);
#pragma unroll
                for (int bj = 0; bj < 2; ++bj) { const f32x4 g = acc[ai][bj][m][0] * rs, up = acc[ai][bj][m][1] * rs; f32x4 s;
#pragma unroll
                    for (int i = 0; i < 4; ++i) s[i] = g[i] * sigmoidf_fast(g[i]) * up[i];
                    u32x2 w; w.x = cvt_pk_bf16(s[0], s[1]); w.y = cvt_pk_bf16(s[2], s[3]);
                    *(u32x2*)(U + (size_t)row * 5632 + ucol0 + bj * 64) = w; } }
    }
};

template <class Epi, class Sched, bool ALIGN_EPI = false, bool SP2 = false>
__device__ __forceinline__ void gemm_phase(PG8_LAS unsigned char* lds, const Gemm g, const Sched& S, const Epi& E) {
    int tid_ = threadIdx.x; asm volatile("" : "+v"(tid_));
    const int tid = tid_, wid = __builtin_amdgcn_readfirstlane(tid >> 6), lane = tid & 63, wr = wid >> 2, wc = wid & 3, fr = lane & 15, fq = lane >> 4;
    const int K = g.K, nt = K / BK;
    unsigned voffA[2], voffB[2];
#pragma unroll
    for (int i = 0; i < 2; ++i) { int R, C; stage_rc(tid * 16 + i * 8192, R, C); const int Rb = Epi::PERM ? ((R & ~31) + perm32(R & 31)) : R;
        voffA[i] = (unsigned)(R * K + C) * 2u; voffB[i] = (unsigned)(Rb * K + C) * 2u; }
    const size_t kstep = (size_t)(BK * 2);
    const size_t hstep = (size_t)HALF * K * 2;
    const size_t tstep = 2 * hstep;
    const unsigned ldsw = (unsigned)wid * 1024u;
    const int aoff = lds_byte(wr * 64 + fr, fq * 8), boff = lds_byte(wc * 32 + fr, fq * 8);
#define PG8_SA(b, h) (((b) * 2 + (h)) * HTB)
#define PG8_SB(b, h) ((4 + (b) * 2 + (h)) * HTB)
#define PG8_STAGE(bufoff, gbase, voff) do { _Pragma("unroll") for (int _i = 0; _i < 2; ++_i) \
        __builtin_amdgcn_global_load_lds((const unsigned*)((const char*)(gbase) + (voff)[_i]), (PG8_LAS unsigned*)(lds + (bufoff) + ldsw + _i * 8192), 16, 0, 0); } while (0)
#define PG8_LDA(dst, b, h) do { _Pragma("unroll") for (int m = 0; m < 4; ++m) _Pragma("unroll") for (int k = 0; k < 2; ++k) dst[m][k] = *(const PG8_LAS bf16x8*)(lds + PG8_SA(b, h) + aoff + m * 2048 + k * 1024); } while (0)
#define PG8_LDB(dst, b, h) do { _Pragma("unroll") for (int n = 0; n < 2; ++n) _Pragma("unroll") for (int k = 0; k < 2; ++k) dst[n][k] = *(const PG8_LAS bf16x8*)(lds + PG8_SB(b, h) + boff + n * 2048 + k * 1024); } while (0)
#define PG8_MMA(ai, bj, At, Bt) do { __builtin_amdgcn_s_setprio(1); _Pragma("unroll") for (int m = 0; m < 4; ++m) _Pragma("unroll") for (int n = 0; n < 2; ++n) _Pragma("unroll") for (int k = 0; k < 2; ++k) \
        acc[ai][bj][m][n] = __builtin_amdgcn_mfma_f32_16x16x32_bf16(Bt[n][k], At[m][k], acc[ai][bj][m][n], 0, 0, 0); __builtin_amdgcn_s_setprio(0); } while (0)
#define PG8_WAIT_V(n) asm volatile("s_waitcnt vmcnt(" #n ")" ::: "memory")
#define PG8_WAIT_L(n) asm volatile("s_waitcnt lgkmcnt(" #n ")" ::: "memory")
#define PG8_BAR __builtin_amdgcn_s_barrier()
#define PG8_SCHED __builtin_amdgcn_sched_barrier(0)
    Unit cur, nxt; int ui = 0;
    if (!S.next(0, cur)) return;
    f32x4 acc[2][2][4][2];
#pragma unroll
    for (int a = 0; a < 2; ++a)
#pragma unroll
        for (int b = 0; b < 2; ++b)
#pragma unroll
            for (int m = 0; m < 4; ++m)
#pragma unroll
                for (int n = 0; n < 2; ++n) acc[a][b][m][n] = (f32x4){0.f, 0.f, 0.f, 0.f};
    bf16x8 At[4][2], B0[2][2], B1[2][2];
    const char* cA = (const char*)g.A + (size_t)cur.pm * tstep; const char* cB = (const char*)g.Bt + (size_t)cur.pn * tstep;
    S.a_ready(cur);
    if constexpr (SP2) {
        PG8_STAGE(PG8_SB(0, 0), cB, voffB); PG8_STAGE(PG8_SB(0, 1), cB + hstep, voffB); PG8_STAGE(PG8_SA(0, 0), cA, voffA); PG8_STAGE(PG8_SA(0, 1), cA + hstep, voffA);
        if (wr == 1) PG8_BAR;
        PG8_WAIT_V(2); PG8_BAR;
        PG8_STAGE(PG8_SB(1, 0), cB + kstep, voffB); PG8_STAGE(PG8_SA(1, 0), cA + kstep, voffA); PG8_STAGE(PG8_SB(1, 1), cB + hstep + kstep, voffB);
        PG8_WAIT_V(6); PG8_BAR;
    } else {
        PG8_STAGE(PG8_SB(0, 0), cB, voffB); PG8_STAGE(PG8_SA(0, 0), cA, voffA); PG8_STAGE(PG8_SB(0, 1), cB + hstep, voffB); PG8_STAGE(PG8_SA(0, 1), cA + hstep, voffA);
        if (wr == 1) PG8_BAR;
        PG8_WAIT_V(4); PG8_BAR;
        PG8_STAGE(PG8_SB(1, 0), cB + kstep, voffB); PG8_STAGE(PG8_SA(1, 0), cA + kstep, voffA); PG8_STAGE(PG8_SB(1, 1), cB + hstep + kstep, voffB);
        PG8_WAIT_V(6); PG8_BAR;
    }
    for (;;) {
        const bool has_next = S.next(ui + 1, nxt);
        const char* nA = has_next ? (const char*)g.A + (size_t)nxt.pm * tstep : cA; const char* nB = has_next ? (const char*)g.Bt + (size_t)nxt.pn * tstep : cB;
        for (int t = 0; t < nt; t += 2) {
            const bool last = (t == nt - 2);
            const char* a1 = cA + (size_t)(t + 1) * kstep;
            const char* a2 = last ? nA : cA + (size_t)(t + 2) * kstep; const char* b2 = last ? nB : cB + (size_t)(t + 2) * kstep;
            const char* a3 = a2 + kstep; const char* b3 = b2 + kstep;
            if (last && has_next) S.a_ready(nxt);
            if constexpr (SP2) {
            PG8_LDB(B0, 0, 0); PG8_LDB(B1, 0, 1); PG8_SCHED; PG8_LDA(At, 0, 0); PG8_STAGE(PG8_SA(1, 1), a1 + hstep, voffA);
            PG8_WAIT_V(8); PG8_WAIT_L(0); PG8_BAR; PG8_MMA(0, 0, At, B0); PG8_MMA(0, 1, At, B1); PG8_BAR; PG8_SCHED;
            PG8_LDA(At, 0, 1); PG8_STAGE(PG8_SB(0, 0), b2, voffB); PG8_STAGE(PG8_SB(0, 1), b2 + hstep, voffB); PG8_STAGE(PG8_SA(0, 0), a2, voffA);
            PG8_WAIT_V(8); PG8_WAIT_L(0); PG8_BAR; PG8_MMA(1, 0, At, B0); PG8_MMA(1, 1, At, B1); PG8_BAR; PG8_SCHED;
            PG8_LDB(B0, 1, 0); PG8_LDB(B1, 1, 1); PG8_SCHED; PG8_LDA(At, 1, 0); PG8_STAGE(PG8_SA(0, 1), a2 + hstep, voffA);
            PG8_WAIT_V(8); PG8_WAIT_L(0); PG8_BAR; PG8_MMA(0, 0, At, B0); PG8_MMA(0, 1, At, B1); PG8_BAR; PG8_SCHED;
            PG8_LDA(At, 1, 1); PG8_STAGE(PG8_SB(1, 0), b3, voffB); PG8_STAGE(PG8_SB(1, 1), b3 + hstep, voffB); PG8_STAGE(PG8_SA(1, 0), a3, voffA);
            PG8_WAIT_V(8); PG8_WAIT_L(0); PG8_BAR; PG8_MMA(1, 0, At, B0); PG8_MMA(1, 1, At, B1); PG8_BAR; PG8_SCHED;
            } else {
            PG8_LDB(B0, 0, 0); PG8_SCHED; PG8_LDA(At, 0, 0); PG8_STAGE(PG8_SA(1, 1), a1 + hstep, voffA);
            PG8_WAIT_L(8); PG8_BAR; PG8_WAIT_L(0); PG8_MMA(0, 0, At, B0); PG8_BAR; PG8_SCHED;
            PG8_LDB(B1, 0, 1); PG8_STAGE(PG8_SB(0, 0), b2, voffB);
            PG8_BAR; PG8_WAIT_L(0); PG8_MMA(0, 1, At, B1); PG8_BAR;
            PG8_LDA(At, 0, 1); PG8_STAGE(PG8_SA(0, 0), a2, voffA);
            PG8_BAR; PG8_WAIT_L(0); PG8_MMA(1, 0, At, B0); PG8_BAR; PG8_SCHED;
            PG8_STAGE(PG8_SB(0, 1), b2 + hstep, voffB);
            PG8_WAIT_V(6); PG8_BAR; PG8_MMA(1, 1, At, B1); PG8_BAR;
            PG8_LDB(B0, 1, 0); PG8_SCHED; PG8_LDA(At, 1, 0); PG8_STAGE(PG8_SA(0, 1), a2 + hstep, voffA);
            PG8_WAIT_L(8); PG8_BAR; PG8_WAIT_L(0); PG8_MMA(0, 0, At, B0); PG8_BAR; PG8_SCHED;
            PG8_LDB(B1, 1, 1); PG8_STAGE(PG8_SB(1, 0), b3, voffB);
            PG8_BAR; PG8_WAIT_L(0); PG8_MMA(0, 1, At, B1); PG8_BAR;
            PG8_LDA(At, 1, 1); PG8_STAGE(PG8_SA(1, 0), a3, voffA);
            PG8_BAR; PG8_WAIT_L(0); PG8_MMA(1, 0, At, B0); PG8_BAR; PG8_SCHED;
            PG8_STAGE(PG8_SB(1, 1), b3 + hstep, voffB);
            PG8_WAIT_V(6); PG8_BAR; PG8_MMA(1, 1, At, B1); PG8_BAR;
            }
        }
        if constexpr (ALIGN_EPI) { if (wr == 0) PG8_BAR; }
        if constexpr (!Epi::AFTER_DRAIN) { E(acc, cur, wr, wc, fr, fq); S.done(cur); }
        if (!has_next) break;
#pragma unroll
        for (int a = 0; a < 2; ++a)
#pragma unroll
            for (int b = 0; b < 2; ++b)
#pragma unroll
                for (int m = 0; m < 4; ++m)
#pragma unroll
                    for (int n = 0; n < 2; ++n) acc[a][b][m][n] = (f32x4){0.f, 0.f, 0.f, 0.f};
        cur = nxt; cA = nA; cB = nB; ++ui;
        if constexpr (ALIGN_EPI) { if (wr == 1) PG8_BAR; }
    }
    PG8_WAIT_V(0);
    if constexpr (!ALIGN_EPI) { if (wr == 0) PG8_BAR; }
    PG8_BAR;
    if constexpr (Epi::AFTER_DRAIN) { E.fused(acc, cur, wr, wc, fr, fq, lds, wid, lane); S.done(cur); }
#undef PG8_SA
#undef PG8_SB
#undef PG8_STAGE
#undef PG8_LDA
#undef PG8_LDB
#undef PG8_MMA
#undef PG8_WAIT_V
#undef PG8_WAIT_L
#undef PG8_BAR
#undef PG8_SCHED
}
}

namespace att {
using bf16 = __hip_bfloat16;
constexpr int   D = 128, NW = 8, QBLK = 32, KVBLK = 64;
constexpr float SCALE = 0.088388347648318440f;
constexpr float THR = 8.f;
#ifndef ATT_SDEPTH
#define ATT_SDEPTH 2
#endif
constexpr int SDEPTH = ATT_SDEPTH;
constexpr int LDQ = 1536, LDK = 1536, LDO = 3072;
constexpr size_t SHM_V = KVBLK * D * 2, SHM_K = KVBLK * D * 2, SHM_ATTN = 2 * SHM_V + 2 * SHM_K + NW * 64 * 4;
using bf16x8 = __attribute__((ext_vector_type(8))) short;
using s16x4  = __attribute__((ext_vector_type(4))) short;
using f32x16 = __attribute__((ext_vector_type(16))) float;
using f32x8  = __attribute__((ext_vector_type(8))) float;
using u32x4  = __attribute__((ext_vector_type(4))) unsigned;
#define KSWZ(row, colB) ((row) * 256 + ((colB) ^ (((row) & 7) << 4)))
#define SBAR() __builtin_amdgcn_sched_barrier(0)
__device__ __forceinline__ int crow(int r, int hi) { return (r & 3) + 8 * (r >> 2) + 4 * hi; }
typedef float cvt_f32x2_t __attribute__((ext_vector_type(2))); typedef __bf16 cvt_bf16x2_t __attribute__((ext_vector_type(2)));
__device__ __forceinline__ unsigned cvtpk(float lo, float hi) {
  cvt_f32x2_t v = {lo, hi}; cvt_bf16x2_t b = __builtin_convertvector(v, cvt_bf16x2_t); return __builtin_bit_cast(unsigned, b);
}
template <typename TIn> struct Stage;
template <> struct Stage<bf16>  { using T = bf16x8;
  __device__ static __forceinline__ T ld8(const bf16* p) { return *reinterpret_cast<const bf16x8*>(p); }
  __device__ static __forceinline__ bf16x8 tobf(T x) { return x; } };
template <> struct Stage<float> { using T = f32x8;
  __device__ static __forceinline__ T ld8(const float* p) { return *reinterpret_cast<const f32x8*>(p); }
  __device__ static __forceinline__ bf16x8 tobf(T x) {
    u32x4 w = {cvtpk(x[0], x[1]), cvtpk(x[2], x[3]), cvtpk(x[4], x[5]), cvtpk(x[6], x[7])}; return *reinterpret_cast<bf16x8*>(&w); } };

__device__ __forceinline__ void partialSM(f32x16& p0, f32x16& p1, float& m_reg, float& mn, float& alpha) {
  constexpr float C = SCALE * 1.4426950408889634f;
  float pmax = p0[0]; for (int r = 1; r < 16; ++r) pmax = fmaxf(pmax, p0[r]); for (int r = 0; r < 16; ++r) pmax = fmaxf(pmax, p1[r]);
  { auto rr = __builtin_amdgcn_permlane32_swap(__float_as_uint(pmax), __float_as_uint(pmax), false, false);
    pmax = fmaxf(__uint_as_float(rr[0]), __uint_as_float(rr[1])); }
  if (__builtin_expect(__all(pmax - m_reg <= THR / SCALE), 1)) { mn = m_reg; alpha = 1.f; }
  else { mn = fmaxf(m_reg, pmax); alpha = __builtin_amdgcn_exp2f((m_reg - mn) * C); m_reg = mn; }
  float mnC = -mn * C;
  for (int r = 0; r < 16; ++r) p0[r] = fmaf(p0[r], C, mnC); for (int r = 0; r < 16; ++r) p1[r] = fmaf(p1[r], C, mnC);
  for (int r = 0; r < 16; ++r) p0[r] = __builtin_amdgcn_exp2f(p0[r]);
}
__device__ __forceinline__ void finishSM(f32x16& p0, f32x16& p1, float alpha, float& l_reg, bf16x8& pa0, bf16x8& pa1, bf16x8& pa2, bf16x8& pa3) {
  for (int r = 0; r < 16; ++r) p1[r] = __builtin_amdgcn_exp2f(p1[r]);
  float ps = 0; for (int r = 0; r < 16; ++r) ps += p0[r]; for (int r = 0; r < 16; ++r) ps += p1[r];
  { auto rr = __builtin_amdgcn_permlane32_swap(__float_as_uint(ps), __float_as_uint(ps), false, false);
    ps = __uint_as_float(rr[0]) + __uint_as_float(rr[1]); }
  l_reg = l_reg * alpha + ps;
#define PK4(P, BASE, OUT) do { unsigned a0 = cvtpk(P[BASE + 0], P[BASE + 1]), a1 = cvtpk(P[BASE + 2], P[BASE + 3]);   \
    unsigned b0 = cvtpk(P[BASE + 4], P[BASE + 5]), b1 = cvtpk(P[BASE + 6], P[BASE + 7]);                              \
    auto r0 = __builtin_amdgcn_permlane32_swap(a0, b0, false, false); auto r1 = __builtin_amdgcn_permlane32_swap(a1, b1, false, false); \
    u32x4 w = {r0[0], r1[0], r0[1], r1[1]}; OUT = *reinterpret_cast<bf16x8*>(&w); } while (0)
  PK4(p0, 0, pa0); PK4(p0, 8, pa1); PK4(p1, 0, pa2); PK4(p1, 8, pa3);
#undef PK4
}
__device__ __forceinline__ void qkt(f32x16& p0, f32x16& p1, const bf16* Ks, const bf16x8* qr, int r32, int hi) {
  p0 = f32x16{}; p1 = f32x16{};
  for (int d0 = 0; d0 < 8; ++d0) { int cb = (d0 * 16 + hi * 8) * 2;
    bf16x8 b0 = *reinterpret_cast<const bf16x8*>((const char*)Ks + KSWZ(r32, cb));
    bf16x8 b1 = *reinterpret_cast<const bf16x8*>((const char*)Ks + KSWZ(32 + r32, cb));
    p0 = __builtin_amdgcn_mfma_f32_32x32x16_bf16(b0, qr[d0], p0, 0, 0, 0);
    p1 = __builtin_amdgcn_mfma_f32_32x32x16_bf16(b1, qr[d0], p1, 0, 0, 0); }
}
__device__ __forceinline__ int v_st(int k, int c) { const int kk = (k & ~0xC) | ((k & 4) << 1) | ((k & 8) >> 1); return ((kk >> 3) * 4 + (c >> 5)) * 512 + ((kk & 7) * 32 + (c & 31)) * 2; }
__device__ __forceinline__ int v_rd_base(int lane) { return ((lane & 3) << 3) | (((lane >> 2) & 3) << 6) | (((lane >> 4) & 1) << 5) | (((lane >> 5) & 1) << 8); }
constexpr int v_rd_off(int d0, int ks, int half) { return d0 * 512 + ks * 4096 + half * 2048; }
template <int OFF> __device__ __forceinline__ s16x4 tr_read(int vb) {
  s16x4 r; asm volatile("ds_read_b64_tr_b16 %0, %1 offset:%2" : "=&v"(r) : "v"(vb), "i"(OFF) : "memory"); return r;
}
template <int D0> __device__ __forceinline__ void pv_one(f32x16& od, int vb, bf16x8 pa0, bf16x8 pa1, bf16x8 pa2, bf16x8 pa3) {
  const s16x4 l0 = tr_read<v_rd_off(D0, 0, 0)>(vb), h0 = tr_read<v_rd_off(D0, 0, 1)>(vb), l1 = tr_read<v_rd_off(D0, 1, 0)>(vb), h1 = tr_read<v_rd_off(D0, 1, 1)>(vb);
  const s16x4 l2 = tr_read<v_rd_off(D0, 2, 0)>(vb), h2 = tr_read<v_rd_off(D0, 2, 1)>(vb), l3 = tr_read<v_rd_off(D0, 3, 0)>(vb), h3 = tr_read<v_rd_off(D0, 3, 1)>(vb);
  asm volatile("s_waitcnt lgkmcnt(0)" ::: "memory"); SBAR();
#define PK(L, H) (bf16x8){L[0], L[1], L[2], L[3], H[0], H[1], H[2], H[3]}
  od = __builtin_amdgcn_mfma_f32_32x32x16_bf16(pa0, PK(l0, h0), od, 0, 0, 0);
  od = __builtin_amdgcn_mfma_f32_32x32x16_bf16(pa1, PK(l1, h1), od, 0, 0, 0);
  od = __builtin_amdgcn_mfma_f32_32x32x16_bf16(pa2, PK(l2, h2), od, 0, 0, 0);
  od = __builtin_amdgcn_mfma_f32_32x32x16_bf16(pa3, PK(l3, h3), od, 0, 0, 0);
#undef PK
}
__device__ __forceinline__ void pv_d0(f32x16* o, int vb, bf16x8 pa0, bf16x8 pa1, bf16x8 pa2, bf16x8 pa3) {
  pv_one<0>(o[0], vb, pa0, pa1, pa2, pa3); pv_one<1>(o[1], vb, pa0, pa1, pa2, pa3); pv_one<2>(o[2], vb, pa0, pa1, pa2, pa3); pv_one<3>(o[3], vb, pa0, pa1, pa2, pa3);
}
template <typename TQ>
__device__ __forceinline__ void attn_dense_body(const TQ* __restrict__ Qb, const bf16* __restrict__ Kh, const bf16* __restrict__ Vh,
                                                bf16* __restrict__ Ob, int seq, char* lds) {
  using St = Stage<bf16>; using SQ = Stage<TQ>;
  int tid_ = threadIdx.x; asm volatile("" : "+v"(tid_));
  const int tid = tid_, wid = tid >> 6, lane = tid & 63, r32 = lane & 31, hi = lane >> 5;
  bf16* V_lds = (bf16*)lds; bf16* K_lds = (bf16*)(lds + 2 * SHM_V);
  float* ws = (float*)(lds + 2 * SHM_V + 2 * SHM_K) + wid * 64; float* li_l = ws; float* al_l = ws + 32;
  float m_reg = -1e30f, l_reg = 0; f32x16 o[4] = {}; bf16x8 qr[8];
  const TQ* Qw = Qb + (long)(wid * QBLK + r32) * LDQ + hi * 8;
#pragma unroll
  for (int d0 = 0; d0 < 8; ++d0) qr[d0] = SQ::tobf(SQ::ld8(Qw + d0 * 16));
  const int sr = tid >> 4, sc = (tid & 15) * 8, vst0 = v_st(sr, sc), vst1 = v_st(32 + sr, sc);
  const int vb0 = (int)(uintptr_t)V_lds + v_rd_base(lane);
  struct { typename St::T vs0, vs1, ks0, ks1; } sr_[SDEPTH];
#define SLOAD(i, k0) do { sr_[i].vs0 = St::ld8(&Vh[(long)((k0) + sr) * LDK + sc]); sr_[i].vs1 = St::ld8(&Vh[(long)((k0) + 32 + sr) * LDK + sc]); \
    sr_[i].ks0 = St::ld8(&Kh[(long)((k0) + sr) * LDK + sc]); sr_[i].ks1 = St::ld8(&Kh[(long)((k0) + 32 + sr) * LDK + sc]); } while (0)
#define SWRITE(b, i) do { *(bf16x8*)((char*)V_lds + (b) * SHM_V + vst0) = St::tobf(sr_[i].vs0);          \
    *(bf16x8*)((char*)V_lds + (b) * SHM_V + vst1) = St::tobf(sr_[i].vs1); int kc = sc * 2;               \
    *(bf16x8*)((char*)K_lds + (b) * SHM_K + KSWZ(sr, kc)) = St::tobf(sr_[i].ks0);                       \
    *(bf16x8*)((char*)K_lds + (b) * SHM_K + KSWZ(32 + sr, kc)) = St::tobf(sr_[i].ks1); } while (0)
#define SWAIT() do { if constexpr (SDEPTH == 2) asm volatile("s_waitcnt vmcnt(4)" ::: "memory"); else asm volatile("s_waitcnt vmcnt(0)" ::: "memory"); } while (0)
#define RESC(a) do { if (__any((a) < 1.f)) { if (hi == 0) al_l[r32] = (a); asm volatile("s_waitcnt lgkmcnt(0)" ::: "memory"); \
    for (int d = 0; d < 4; ++d) for (int r = 0; r < 16; ++r) o[d][r] *= al_l[crow(r, hi)]; } } while (0)
  f32x16 pA0, pA1, pB0, pB1; float mnA, mnB, alA, alB; bf16x8 pa0, pa1, pa2, pa3; const int NT = seq / KVBLK;
  constexpr int SE = 0, SO = SDEPTH - 1;
  SLOAD(SE, 0); asm volatile("s_waitcnt vmcnt(0)" ::: "memory"); SWRITE(0, SE); __syncthreads();
  qkt(pA0, pA1, K_lds, qr, r32, hi); partialSM(pA0, pA1, m_reg, mnA, alA);
  SLOAD(SO, KVBLK); if constexpr (SDEPTH == 2) { if (2 < NT) SLOAD(SE, 2 * KVBLK); }
  SWAIT(); SWRITE(1, SO); __syncthreads();
  for (int j = 1; j + 1 < NT; j += 2) {
    SBAR(); qkt(pB0, pB1, (bf16*)((char*)K_lds + SHM_K), qr, r32, hi);
    finishSM(pA0, pA1, alA, l_reg, pa0, pa1, pa2, pa3); SBAR();
    SLOAD(SO, (j + SDEPTH) * KVBLK); SBAR();
    pv_d0(o, vb0, pa0, pa1, pa2, pa3); partialSM(pB0, pB1, m_reg, mnB, alB);
    __syncthreads(); SWAIT(); SWRITE(0, SE);
    RESC(alB); __syncthreads();
    SBAR(); qkt(pA0, pA1, K_lds, qr, r32, hi);
    finishSM(pB0, pB1, alB, l_reg, pa0, pa1, pa2, pa3); SBAR();
    if (SDEPTH == 1 || j + 3 < NT) SLOAD(SE, (j + 1 + SDEPTH) * KVBLK); SBAR();
    pv_d0(o, vb0 + (int)SHM_V, pa0, pa1, pa2, pa3); partialSM(pA0, pA1, m_reg, mnA, alA);
    __syncthreads(); SWAIT(); SWRITE(1, SO);
    RESC(alA); __syncthreads();
  }
  SBAR(); qkt(pB0, pB1, (bf16*)((char*)K_lds + SHM_K), qr, r32, hi);
  finishSM(pA0, pA1, alA, l_reg, pa0, pa1, pa2, pa3); SBAR();
  pv_d0(o, vb0, pa0, pa1, pa2, pa3); partialSM(pB0, pB1, m_reg, mnB, alB);
  __syncthreads(); RESC(alB);
  finishSM(pB0, pB1, alB, l_reg, pa0, pa1, pa2, pa3); SBAR();
  pv_d0(o, vb0 + (int)SHM_V, pa0, pa1, pa2, pa3);
  if (hi == 0) li_l[r32] = l_reg; asm volatile("s_waitcnt lgkmcnt(0)" ::: "memory");
  float rli[16];
#pragma unroll
  for (int r = 0; r < 16; ++r) rli[r] = __builtin_amdgcn_rcpf(li_l[crow(r, hi)]);
  bf16* Ow = Ob + (long)(wid * QBLK) * LDO;
#pragma unroll
  for (int r = 0; r < 16; ++r) { int orow = crow(r, hi);
    for (int d0 = 0; d0 < 4; ++d0) Ow[(long)orow * LDO + d0 * 32 + r32] = __float2bfloat16(o[d0][r] * rli[r]); }
#undef SLOAD
#undef SWRITE
#undef SWAIT
#undef RESC
}

constexpr int PC_K = 0, PC_V = 32768, PC_XP = 98304, PC_XAL = 131072, PC_LI = 133120, PC_LDS_BYTES = 133632;
struct PCStage { bf16x8 k0, k1, v00, v01, v10, v11; };
__device__ __forceinline__ void pc_sload(PCStage& st, const bf16* __restrict__ Kh, const bf16* __restrict__ Vh, bool doK, int kK, bool doV, int kV, int sr, int sc) {
  if (doK) { st.k0  = *reinterpret_cast<const bf16x8*>(Kh + (long)(kK + sr) * LDK + sc);       st.k1  = *reinterpret_cast<const bf16x8*>(Kh + (long)(kK + 32 + sr) * LDK + sc); }
  if (doV) { st.v00 = *reinterpret_cast<const bf16x8*>(Vh + (long)(kV + sr) * LDK + sc);       st.v01 = *reinterpret_cast<const bf16x8*>(Vh + (long)(kV + 32 + sr) * LDK + sc);
             st.v10 = *reinterpret_cast<const bf16x8*>(Vh + (long)(kV + sr) * LDK + 128 + sc); st.v11 = *reinterpret_cast<const bf16x8*>(Vh + (long)(kV + 32 + sr) * LDK + 128 + sc); }
}
__device__ __forceinline__ void pc_swrite(const PCStage& st, char* lds, bool doK, int kbuf, bool doV, int vbuf, int sr, int sc, int vst0, int vst1) {
  if (doK) { char* K_ = lds + PC_K + kbuf * 16384; const int kc = sc * 2;
    *reinterpret_cast<bf16x8*>(K_ + KSWZ(sr, kc)) = st.k0; *reinterpret_cast<bf16x8*>(K_ + KSWZ(32 + sr, kc)) = st.k1; }
  if (doV) { char* V0 = lds + PC_V + (vbuf * 2) * 16384; char* V1 = V0 + 16384;
    *reinterpret_cast<bf16x8*>(V0 + vst0) = st.v00; *reinterpret_cast<bf16x8*>(V0 + vst1) = st.v01;
    *reinterpret_cast<bf16x8*>(V1 + vst0) = st.v10; *reinterpret_cast<bf16x8*>(V1 + vst1) = st.v11; }
}
__device__ __forceinline__ void pc_consume(f32x16 (&o)[8], char* lds, int vbase, int pbuf, int pw, int lane, int hi) {
  const float* xa = reinterpret_cast<const float*>(lds + PC_XAL + (pbuf * 4 + pw) * 256);
  if (__builtin_amdgcn_readfirstlane(__float_as_int(xa[32])) != 0) {
#pragma unroll
    for (int r = 0; r < 16; ++r) { const float a = xa[crow(r, hi)];
#pragma unroll
      for (int d = 0; d < 8; ++d) o[d][r] *= a; }
  }
  const u32x4* xp = reinterpret_cast<const u32x4*>(lds + PC_XP + (pbuf * 4 + pw) * 4096) + lane;
  const u32x4 w0 = xp[0], w1 = xp[64], w2 = xp[128], w3 = xp[192];
  const bf16x8 pa0 = __builtin_bit_cast(bf16x8, w0), pa1 = __builtin_bit_cast(bf16x8, w1), pa2 = __builtin_bit_cast(bf16x8, w2), pa3 = __builtin_bit_cast(bf16x8, w3);
  const int vb0 = vbase + (pbuf * 2) * 16384, vb1 = vb0 + 16384;
  pv_one<0>(o[0], vb0, pa0, pa1, pa2, pa3); pv_one<1>(o[1], vb0, pa0, pa1, pa2, pa3); pv_one<2>(o[2], vb0, pa0, pa1, pa2, pa3); pv_one<3>(o[3], vb0, pa0, pa1, pa2, pa3);
  pv_one<0>(o[4], vb1, pa0, pa1, pa2, pa3); pv_one<1>(o[5], vb1, pa0, pa1, pa2, pa3); pv_one<2>(o[6], vb1, pa0, pa1, pa2, pa3); pv_one<3>(o[7], vb1, pa0, pa1, pa2, pa3);
}
template <int D0> __device__ __forceinline__ void pv_two(f32x16& oa, f32x16& ob, int vb, bf16x8 a0, bf16x8 a1, bf16x8 a2, bf16x8 a3, bf16x8 b0, bf16x8 b1, bf16x8 b2, bf16x8 b3) {
  const s16x4 l0 = tr_read<v_rd_off(D0, 0, 0)>(vb), h0 = tr_read<v_rd_off(D0, 0, 1)>(vb), l1 = tr_read<v_rd_off(D0, 1, 0)>(vb), h1 = tr_read<v_rd_off(D0, 1, 1)>(vb);
  const s16x4 l2 = tr_read<v_rd_off(D0, 2, 0)>(vb), h2 = tr_read<v_rd_off(D0, 2, 1)>(vb), l3 = tr_read<v_rd_off(D0, 3, 0)>(vb), h3 = tr_read<v_rd_off(D0, 3, 1)>(vb);
  asm volatile("s_waitcnt lgkmcnt(0)" ::: "memory"); SBAR();
#define PK(L, H) (bf16x8){L[0], L[1], L[2], L[3], H[0], H[1], H[2], H[3]}
  oa = __builtin_amdgcn_mfma_f32_32x32x16_bf16(a0, PK(l0, h0), oa, 0, 0, 0); ob = __builtin_amdgcn_mfma_f32_32x32x16_bf16(b0, PK(l0, h0), ob, 0, 0, 0);
  oa = __builtin_amdgcn_mfma_f32_32x32x16_bf16(a1, PK(l1, h1), oa, 0, 0, 0); ob = __builtin_amdgcn_mfma_f32_32x32x16_bf16(b1, PK(l1, h1), ob, 0, 0, 0);
  oa = __builtin_amdgcn_mfma_f32_32x32x16_bf16(a2, PK(l2, h2), oa, 0, 0, 0); ob = __builtin_amdgcn_mfma_f32_32x32x16_bf16(b2, PK(l2, h2), ob, 0, 0, 0);
  oa = __builtin_amdgcn_mfma_f32_32x32x16_bf16(a3, PK(l3, h3), oa, 0, 0, 0); ob = __builtin_amdgcn_mfma_f32_32x32x16_bf16(b3, PK(l3, h3), ob, 0, 0, 0);
#undef PK
}
__device__ __forceinline__ void pc_consume2(f32x16 (&o)[8], char* lds, int vbh  , int pbuf, int rg2, int lane, int hi) {
  const int sa = pbuf * 4 + 2 * rg2;
  const float* xaA = reinterpret_cast<const float*>(lds + PC_XAL + sa * 256); const float* xaB = xaA + 64;
  if (__builtin_amdgcn_readfirstlane(__float_as_int(xaA[32])) != 0) {
#pragma unroll
    for (int r = 0; r < 16; ++r) { const float a = xaA[crow(r, hi)];
#pragma unroll
      for (int d = 0; d < 4; ++d) o[d][r] *= a; } }
  if (__builtin_amdgcn_readfirstlane(__float_as_int(xaB[32])) != 0) {
#pragma unroll
    for (int r = 0; r < 16; ++r) { const float a = xaB[crow(r, hi)];
#pragma unroll
      for (int d = 0; d < 4; ++d) o[4 + d][r] *= a; } }
  const u32x4* xpA = reinterpret_cast<const u32x4*>(lds + PC_XP + sa * 4096) + lane; const u32x4* xpB = xpA + 256;
  const u32x4 wa0 = xpA[0], wa1 = xpA[64], wa2 = xpA[128], wa3 = xpA[192], wb0 = xpB[0], wb1 = xpB[64], wb2 = xpB[128], wb3 = xpB[192];
  const bf16x8 a0 = __builtin_bit_cast(bf16x8, wa0), a1 = __builtin_bit_cast(bf16x8, wa1), a2 = __builtin_bit_cast(bf16x8, wa2), a3 = __builtin_bit_cast(bf16x8, wa3);
  const bf16x8 b0 = __builtin_bit_cast(bf16x8, wb0), b1 = __builtin_bit_cast(bf16x8, wb1), b2 = __builtin_bit_cast(bf16x8, wb2), b3 = __builtin_bit_cast(bf16x8, wb3);
  const int vb = vbh + (pbuf * 2) * 16384;
  pv_two<0>(o[0], o[4], vb, a0, a1, a2, a3, b0, b1, b2, b3); pv_two<1>(o[1], o[5], vb, a0, a1, a2, a3, b0, b1, b2, b3);
  pv_two<2>(o[2], o[6], vb, a0, a1, a2, a3, b0, b1, b2, b3); pv_two<3>(o[3], o[7], vb, a0, a1, a2, a3, b0, b1, b2, b3);
}
__device__ __forceinline__ void attn_pc_unit(const bf16* __restrict__ Qb, const bf16* __restrict__ Kh, const bf16* __restrict__ Vh, bf16* __restrict__ Ob, char* lds, int rot) {
#define PC_KT(X) ((((X) + rot) & (NT - 1)) * KVBLK)
  int tid_ = threadIdx.x; asm volatile("" : "+v"(tid_));
  const int tid = tid_, lane = tid & 63, r32 = lane & 31, hi = lane >> 5;
  const int wid = __builtin_amdgcn_readfirstlane(tid >> 6), pw = wid & 3;
  const int sr = tid >> 4, sc = (tid & 15) * 8, vst0 = v_st(sr, sc), vst1 = v_st(32 + sr, sc);
  constexpr int NT = 4096 / KVBLK;
  PCStage st;
  pc_sload(st, Kh, Vh, true, PC_KT(0), false, 0, sr, sc); pc_swrite(st, lds, true, 0, false, 0, sr, sc, vst0, vst1);
  pc_sload(st, Kh, Vh, true, PC_KT(1), true, PC_KT(0), sr, sc);
  if (wid < 4) {
    bf16x8 qr[8]; const bf16* Qw = Qb + (long)(pw * QBLK + r32) * LDQ + hi * 8;
#pragma unroll
    for (int d0 = 0; d0 < 8; ++d0) qr[d0] = *reinterpret_cast<const bf16x8*>(Qw + d0 * 16);
    float m_reg = -1e30f, l_reg = 0.f;
    __syncthreads();
    for (int j = 0; j < NT; ++j) {
      const int buf = j & 1;
      pc_swrite(st, lds, j + 1 < NT, buf ^ 1, true, buf, sr, sc, vst0, vst1);
      pc_sload(st, Kh, Vh, j + 2 < NT, PC_KT(j + 2), j + 1 < NT, PC_KT(j + 1), sr, sc);
      f32x16 p0, p1; float mn, alpha; bf16x8 pa0, pa1, pa2, pa3;
      SBAR(); qkt(p0, p1, reinterpret_cast<const bf16*>(lds + PC_K + buf * 16384), qr, r32, hi);
      partialSM(p0, p1, m_reg, mn, alpha); finishSM(p0, p1, alpha, l_reg, pa0, pa1, pa2, pa3);
      { u32x4* xp = reinterpret_cast<u32x4*>(lds + PC_XP + (buf * 4 + pw) * 4096) + lane;
        xp[0] = __builtin_bit_cast(u32x4, pa0); xp[64] = __builtin_bit_cast(u32x4, pa1); xp[128] = __builtin_bit_cast(u32x4, pa2); xp[192] = __builtin_bit_cast(u32x4, pa3);
        float* xa = reinterpret_cast<float*>(lds + PC_XAL + (buf * 4 + pw) * 256);
        const float fl = __any(alpha < 1.f) ? 1.f : 0.f;
        if (hi == 0) xa[r32] = alpha;
        if (lane == 0) xa[32] = fl; }
      __syncthreads();
    }
    if (hi == 0) reinterpret_cast<float*>(lds + PC_LI)[pw * 32 + r32] = l_reg;
    __syncthreads();
    __syncthreads();
  } else {
    f32x16 o[8] = {};
    const int rg2 = pw & 1, vh = pw >> 1;
    const int vbh = (int)(uintptr_t)(lds + PC_V) + vh * 16384 + v_rd_base(lane);
    __syncthreads();
    for (int j = 0; j < NT; ++j) {
      const int buf = j & 1;
      pc_swrite(st, lds, j + 1 < NT, buf ^ 1, true, buf, sr, sc, vst0, vst1);
      pc_sload(st, Kh, Vh, j + 2 < NT, PC_KT(j + 2), j + 1 < NT, PC_KT(j + 1), sr, sc);
      if (j > 0) pc_consume2(o, lds, vbh, buf ^ 1, rg2, lane, hi);
      __syncthreads();
    }
    pc_consume2(o, lds, vbh, (NT - 1) & 1, rg2, lane, hi);
    __syncthreads();
    const float* li = reinterpret_cast<const float*>(lds + PC_LI) + (2 * rg2) * 32;
    float rla[16], rlb[16];
#pragma unroll
    for (int r = 0; r < 16; ++r) { rla[r] = __builtin_amdgcn_rcpf(li[crow(r, hi)]); rlb[r] = __builtin_amdgcn_rcpf(li[32 + crow(r, hi)]); }
    bf16* Ow = Ob + (long)(2 * rg2 * QBLK) * LDO + vh * 128;
#pragma unroll
    for (int r = 0; r < 16; ++r) { const int orow = crow(r, hi);
#pragma unroll
      for (int d0 = 0; d0 < 4; ++d0) { Ow[(long)orow * LDO + d0 * 32 + r32] = __float2bfloat16(o[d0][r] * rla[r]); Ow[(long)(QBLK + orow) * LDO + d0 * 32 + r32] = __float2bfloat16(o[4 + d0][r] * rlb[r]); } }
    __syncthreads();
  }
}
#undef PC_KT
#undef SBAR
#undef KSWZ
}

#ifndef MK_PER_PHASE
#define MK_PER_PHASE 0
#endif
#define GAS __attribute__((address_space(1)))
#define LAS __attribute__((address_space(3)))
typedef unsigned short bf16;
typedef unsigned v4u __attribute__((ext_vector_type(4)));
typedef unsigned v2u __attribute__((ext_vector_type(2)));
typedef float f32x4 __attribute__((ext_vector_type(4)));
#define LDS_WAIT() asm volatile("s_waitcnt lgkmcnt(0)" ::: "memory")

constexpr int NWAVES = 8, NTHREADS = 512;
constexpr int BATCH = 4, SEQ = 4096, DM = 2048, M = BATCH * SEQ;
constexpr int NH = 6, QKW = 1536, VW = 1536, FW = 512, INW = 9216, DFF = 5632;
constexpr float RMS_EPS = 1e-5f, LAMBDA_INIT = 0.2f;
constexpr int NPHASES = 10;
constexpr size_t MiB = 1u << 20;
constexpr size_t WS_INV0 = 0, WS_SS1 = 64 * 1024, WS_SS2 = 128 * 1024, WS_BAR = 192 * 1024  , WS_BAR_BYTES = 16384, WS_ROPE = 256 * 1024;
constexpr size_t WS_WIN = 1 * MiB, WS_WA = 37 * MiB, WS_WCS = 43 * MiB, WS_WOUT = 47 * MiB, WS_WGU = 55 * MiB, WS_WDN = 99 * MiB;
constexpr size_t WS_ADFT = 121 * MiB;
constexpr size_t WS_Q = 185 * MiB, WS_K = 233 * MiB, WS_V = 281 * MiB, WS_FT = 329 * MiB, WS_GA = 345 * MiB, WS_GF = 409 * MiB, WS_F = 473 * MiB, WS_END = 489 * MiB;
constexpr size_t WS_O = WS_Q;
constexpr size_t WS_G = 297 * MiB;
constexpr size_t WS_P1 = WS_K;
constexpr size_t WS_MG = WS_ADFT;
constexpr size_t WS_X1G = WS_GF;
constexpr size_t WS_U = WS_Q;
static_assert(WS_U + (size_t)M * DFF * 2 <= WS_GF, "u must not reach x1g");
constexpr size_t DO_XG = 0, DO_OPC = 0, DO_G = 96 * MiB;
constexpr int LDS_BYTES = 147456;

struct Args { const float* in[16]; float* out; unsigned char* ws; int ph_lo, ph_hi, rmask, pad; };

__device__ __forceinline__ unsigned f2bf(float f) { unsigned u = __builtin_bit_cast(unsigned, f); return (u + 0x7fffu + ((u >> 16) & 1u)) >> 16; }
__device__ __forceinline__ unsigned pk2(float lo, float hi) { return f2bf(lo) | (f2bf(hi) << 16); }
__device__ __forceinline__ float wave_sum(float v) {
#pragma unroll
    for (int o = 1; o < 64; o <<= 1) v += __shfl_xor(v, o);
    return v;
}
static __device__ const double INVF[16] = {1.0, 0.44036660267178046, 0.19392274474868576, 0.08539710028576561, 0.03760603093086393, 0.016560440080994446, 0.007292664737217109,
    0.003211445994752591, 0.001414213562373095, 0.000622772421914596, 0.0002742481756762073, 0.00012076973741146504, 5.318295896944988e-05, 2.341999896140934e-05,
    1.031338537721246e-05, 4.5416704806078695e-06};

__device__ __forceinline__ void tr_item(const float* cp, int dl4, size_t ld, int K, bf16* WTblk  , LAS float* scr, int lane) {
    f32x4 v[8];
#pragma unroll
    for (int i = 0; i < 8; ++i) v[i] = *(const f32x4*)(cp + (size_t)(8 * i) * ld);
    LAS float* d = scr + (lane >> 3) * 33 + dl4;
#pragma unroll
    for (int i = 0; i < 8; ++i) { d[(8 * i) * 33 + 0] = v[i].x; d[(8 * i) * 33 + 1] = v[i].y; d[(8 * i) * 33 + 2] = v[i].z; d[(8 * i) * 33 + 3] = v[i].w; }
    LDS_WAIT(); asm volatile("" ::: "memory");
    const int c = lane & 7;
#pragma unroll
    for (int j = 0; j < 4; ++j) { const int n = (lane >> 3) + 8 * j; const LAS float* s = scr + (8 * c) * 33 + n;
        v4u o; o.x = pk2(s[0 * 33], s[1 * 33]); o.y = pk2(s[2 * 33], s[3 * 33]); o.z = pk2(s[4 * 33], s[5 * 33]); o.w = pk2(s[6 * 33], s[7 * 33]);
        *(v4u*)(WTblk + (size_t)n * K + 8 * c) = o; }
    LDS_WAIT(); asm volatile("" ::: "memory");
}

#define XB_TMO      128
#define XB_XCNT(j)  (256  + 64 * (j))
#define XB_XSUB(j)  (1280 + 64 * (j))
#define XB_XGEN(j)  (2304 + 64 * (j))
#define XB_TOP      3328
#define XB_TOPGEN   3392
#define XCD_BAR_WORDS 3456
#define XB_SPIN_CAP (1u << 18)

__device__ __forceinline__ unsigned xb_ld(unsigned* p)              { return __hip_atomic_load(p, __ATOMIC_RELAXED, __HIP_MEMORY_SCOPE_AGENT); }
__device__ __forceinline__ unsigned xb_add(unsigned* p, unsigned v) { return __hip_atomic_fetch_add(p, v, __ATOMIC_RELAXED, __HIP_MEMORY_SCOPE_AGENT); }
__device__ __forceinline__ unsigned xb_xcc_id() { return (unsigned)__builtin_amdgcn_s_getreg((3 << 11) | 20) & 0xFu; }
#define XB_SPIN(cond, bar) do { unsigned _sp = 0; while (cond) { __builtin_amdgcn_s_sleep(1); \
    if ((++_sp & 255u) == 0u) { if (xb_ld(&(bar)[XB_TMO])) break; if (_sp > XB_SPIN_CAP) { atomicAdd(&(bar)[XB_TMO], 1u); break; } } } } while (0)

struct XcdBarrier {
    unsigned* bar; unsigned x;
    volatile LAS unsigned* st;
};

__device__ __forceinline__ XcdBarrier xcd_barrier_post(unsigned* bar, volatile LAS unsigned* st) {
    XcdBarrier b; b.bar = bar; b.x = xb_xcc_id(); b.st = st;
    if (threadIdx.x == 0) (void)xb_add(&bar[XB_XCNT(b.x)], 1u);
    return b;
}
__device__ __forceinline__ void xcd_barrier_complete(unsigned* bar, unsigned x, unsigned& nloc, unsigned& nx) {
    const unsigned G = gridDim.x * gridDim.y * gridDim.z;
    unsigned sum, cnt, mine, sp = 0u;
    for (;;) {
        sum = 0u; cnt = 0u; mine = 0u;
#pragma unroll
        for (unsigned j = 0; j < 16; ++j) { const unsigned c = xb_ld(&bar[XB_XCNT(j)]); sum += c; cnt += (c > 0u) ? 1u : 0u; mine = (j == x) ? c : mine; }
        if (sum == G) break;
        __builtin_amdgcn_s_sleep(1);
        if ((++sp & 255u) == 0u) { if (xb_ld(&bar[XB_TMO])) break; if (sp > XB_SPIN_CAP) { atomicAdd(&bar[XB_TMO], 1u); break; } }
    }
    nloc = mine > 0u ? mine : 1u; nx = cnt > 0u ? cnt : 1u;
}

__device__ __forceinline__ void xcd_barrier(const XcdBarrier& b) {
    asm volatile("s_waitcnt vmcnt(0)" ::: "memory");
    __syncthreads();
    if (threadIdx.x == 0) {
        unsigned* bar = b.bar;
        __builtin_amdgcn_s_waitcnt(0);
        unsigned nloc = b.st[0], nx = b.st[1];
        if (nloc == 0u) { xcd_barrier_complete(bar, b.x, nloc, nx); b.st[0] = nloc; b.st[1] = nx; }
        const unsigned old = xb_add(&bar[XB_XSUB(b.x)], 1u);
        const unsigned gen = old / nloc;
        if (old + 1u == (gen + 1u) * nloc) {
            __builtin_amdgcn_fence(__ATOMIC_RELEASE, "agent");
            asm volatile("s_waitcnt vmcnt(0)" ::: "memory");
            const unsigned og = xb_add(&bar[XB_TOP], 1u);
            const unsigned tg = og / nx;
            if (og + 1u == (tg + 1u) * nx) xb_add(&bar[XB_TOPGEN], 1u);
            else XB_SPIN(xb_ld(&bar[XB_TOPGEN]) == tg, bar);
            __builtin_amdgcn_fence(__ATOMIC_ACQUIRE, "agent");
            xb_add(&bar[XB_XGEN(b.x)], 1u);
            asm volatile("s_waitcnt vmcnt(0)" ::: "memory");
        } else {
            XB_SPIN(xb_ld(&bar[XB_XGEN(b.x)]) == gen, bar);
            __builtin_amdgcn_fence(__ATOMIC_ACQUIRE, "agent");
            asm volatile("s_waitcnt vmcnt(0)" ::: "memory");
        }
    }
    __syncthreads();
}

__global__ void __launch_bounds__(NTHREADS, 2) mk_fwd(Args args) {
    extern __shared__ __attribute__((aligned(16))) unsigned char lds[];
    cg::grid_group grid = cg::this_grid();
    const int tid = threadIdx.x, lane = tid & 63, wave = __builtin_amdgcn_readfirstlane(tid >> 6);
    const int G = gridDim.x, bx = blockIdx.x, vcu = (G % 8 == 0) ? (bx % 8) * (G / 8) + bx / 8 : bx;
    const int gw = vcu * NWAVES + wave, NGW = G * NWAVES;
    const bool hwbx_is_zero = (blockIdx.x == 0);
    volatile LAS unsigned* xbst = (volatile LAS unsigned*)((LAS unsigned char*)lds + LDS_BYTES - 16);
    if (tid == 0) { xbst[0] = 0u; xbst[1] = 0u; }
    if (hwbx_is_zero) { unsigned* bw = (unsigned*)(args.ws + WS_BAR); for (int i = tid; i < XCD_BAR_WORDS; i += NTHREADS) bw[i] = 0u; }
    __syncthreads();
    XcdBarrier xbar; xbar.bar = (unsigned*)(args.ws + WS_BAR); xbar.x = 0; xbar.st = xbst;
    const long gtid = (long)bx * NTHREADS + tid, NGT = (long)G * NTHREADS;
    unsigned char* ws = args.ws; unsigned char* dout = (unsigned char*)args.out;
    const float* x = args.in[0]; const float* g_mix = args.in[1]; const float* w_in = args.in[2];
    const float* lq1 = args.in[3]; const float* lk1 = args.in[4]; const float* lq2 = args.in[5]; const float* lk2 = args.in[6];
    const float* g_subln = args.in[7]; const float* w_attn = args.in[8]; const float* w_four = args.in[9]; const float* w_out = args.in[10];
    const float* g_ffn = args.in[11]; const float* w_gate = args.in[12]; const float* w_up = args.in[13]; const float* w_down = args.in[14]; const float* g_final = args.in[15];
    float* inv0 = (float*)(ws + WS_INV0); float* ss1 = (float*)(ws + WS_SS1); float* ss2 = (float*)(ws + WS_SS2); float* rope = (float*)(ws + WS_ROPE);
    bf16* WIN = (bf16*)(ws + WS_WIN); bf16* WA = (bf16*)(ws + WS_WA); bf16* WCS = (bf16*)(ws + WS_WCS); bf16* WOUT = (bf16*)(ws + WS_WOUT); bf16* WGU = (bf16*)(ws + WS_WGU); bf16* WDN = (bf16*)(ws + WS_WDN);
    bf16* ADFT = (bf16*)(ws + WS_ADFT);
    bf16* Qb = (bf16*)(ws + WS_Q); bf16* Kb = (bf16*)(ws + WS_K); bf16* Vb = (bf16*)(ws + WS_V); bf16* FT = (bf16*)(ws + WS_FT); bf16* Fb = (bf16*)(ws + WS_F); bf16* GAb = (bf16*)(ws + WS_GA); bf16* GFb = (bf16*)(ws + WS_GF);
    bf16* Ob = (bf16*)(ws + WS_O); bf16* P1 = (bf16*)(ws + WS_P1); bf16* MG = (bf16*)(ws + WS_MG); bf16* X1G = (bf16*)(ws + WS_X1G); bf16* Ub = (bf16*)(ws + WS_U);
    bf16* XG = (bf16*)(dout + DO_XG); bf16* OPC = (bf16*)(dout + DO_OPC);
#if defined(MK_PROBE) && MK_PROBE == 5
    bf16* Gb = (bf16*)(ws + WS_V);
#else
    bf16* Gb = (bf16*)(ws + WS_G);
#endif
    LAS unsigned char* glds = (LAS unsigned char*)lds;

    const int lo = args.ph_lo, hi = args.ph_hi, rmask = args.rmask;
#ifndef MK_PHASE_MASK
#define MK_PHASE_MASK 0x3ff
#endif
#define IN(k) ((((MK_PHASE_MASK) >> (k)) & 1) && ((rmask >> (k)) & 1) && lo <= (k) && (k) < hi)
#define SEAM(k) do { if (IN(k) && IN((k) + 1)) { if ((k) == 0) { grid.sync(); xbar = xcd_barrier_post((unsigned*)(args.ws + WS_BAR), xbst); } else xcd_barrier(xbar); } } while (0)
#ifndef MK_REPEAT
#define MK_REPEAT -1
#endif
#define REP(k) for (int rep_ = 0; rep_ < ((k) == MK_REPEAT ? 2 : 1); ++rep_)

#if defined(MK_SELFPOISON)
    { const v4u pz = {0xAAAAAAAAu, 0xAAAAAAAAu, 0xAAAAAAAAu, 0xAAAAAAAAu};
      v4u* zp = (v4u*)ws; const size_t n16 = (size_t)WS_END / 16; for (size_t i = (size_t)gtid; i < n16; i += (size_t)NGT) zp[i] = pz;
      v4u* op = (v4u*)dout; const size_t o16 = (size_t)M * DM * 4 / 16; for (size_t i = (size_t)gtid; i < o16; i += (size_t)NGT) op[i] = pz;
      grid.sync(); }
#endif
    REP(0) if (IN(0)) {
        for (long i = gtid; i < 2 * M; i += NGT) ss1[i] = 0.f;
#if defined(MK_NANFILL)
        { v4u* zp = (v4u*)(ws + WS_Q); const size_t n16 = (size_t)(WS_END - WS_Q) / 16; const v4u nanv = {0x7fc07fc0u, 0x7fc07fc0u, 0x7fc07fc0u, 0x7fc07fc0u};
          for (size_t i = (size_t)gtid; i < n16; i += (size_t)NGT) zp[i] = nanv; }
#endif
        for (int m = gw; m < M; m += NGW) {
            const GAS f32x4* xr = (const GAS f32x4*)(x + (size_t)m * DM) + lane; const f32x4* g4 = (const f32x4*)g_mix + lane;
            f32x4 v[8]; float s = 0.f;
#pragma unroll
            for (int j = 0; j < 8; ++j) { v[j] = xr[64 * j]; s += (v[j].x * v[j].x + v[j].y * v[j].y) + (v[j].z * v[j].z + v[j].w * v[j].w); }
            s = wave_sum(s);
            if (lane == 0) inv0[m] = 1.0f / sqrtf(s * (1.0f / DM) + RMS_EPS);
            v2u* o8 = (v2u*)(XG + (size_t)m * DM) + lane;
#pragma unroll
            for (int j = 0; j < 8; ++j) { const f32x4 g = g4[64 * j]; v2u w; w.x = pk2(v[j].x * g.x, v[j].y * g.y); w.y = pk2(v[j].z * g.z, v[j].w * g.w); o8[64 * j] = w; }
        }
        {
            LAS float* scr = (LAS float*)((LAS unsigned char*)lds + wave * 16384);
            constexpr int I_IN = (DM / 64) * (INW / 32), I_A = (VW / 64) * (DM / 32), I_O = (DM / 64) * (DM / 32), I_GU = (DM / 64) * (2 * DFF / 32), I_DN = (DFF / 64) * (DM / 32);
            constexpr int NITEMS = I_IN + I_A + I_O + I_GU + I_DN;
            const int q = lane & 7, q4 = q * 4, kr = lane >> 3;
            for (int it = gw; it < NITEMS; it += NGW) {
                int r = it;
                if (r < I_IN) { const int nblk = INW / 32, kb = r / nblk, nb = r % nblk; tr_item(w_in + (size_t)(64 * kb + kr) * INW + 32 * nb + q4, q4, INW, DM, WIN + (size_t)(32 * nb) * DM + 64 * kb, scr, lane); continue; } r -= I_IN;
                if (r < I_A) { const int nblk = DM / 32, kb = r / nblk, nb = r % nblk; tr_item(w_attn + (size_t)(64 * kb + kr) * DM + 32 * nb + q4, q4, DM, VW, WA + (size_t)(32 * nb) * VW + 64 * kb, scr, lane); continue; } r -= I_A;
                if (r < I_O) { const int nblk = DM / 32, kb = r / nblk, nb = r % nblk; tr_item(w_out + (size_t)(64 * kb + kr) * DM + 32 * nb + q4, q4, DM, DM, WOUT + (size_t)(32 * nb) * DM + 64 * kb, scr, lane); continue; } r -= I_O;
                if (r < I_GU) { const int nblk = 2 * DFF / 32, kb = r / nblk, nb = r % nblk;
                    const int nn = q >> 2, j = (q & 3) * 4, dl4 = 8 * (q & 3) + 4 * nn;
                    tr_item((nn ? w_up : w_gate) + (size_t)(64 * kb + kr) * DFF + 16 * nb + j, dl4, DFF, DM, WGU + (size_t)(32 * nb) * DM + 64 * kb, scr, lane); continue; } r -= I_GU;
                { const int nblk = DM / 32, kb = r / nblk, nb = r % nblk; tr_item(w_down + (size_t)(64 * kb + kr) * DM + 32 * nb + q4, q4, DM, DFF, WDN + (size_t)(32 * nb) * DFF + 64 * kb, scr, lane); }
            }
        }
        for (long t = gtid; t < (long)4096 * 256; t += NGT) {
            const int m = (int)(t >> 8), s0 = (int)(t & 255) * 8, part = m >> 11, k = 2 * (m & 1023) + ((m >> 10) & 1); float v[8];
#pragma unroll
            for (int e = 0; e < 8; ++e) { const float ph = (float)((k * (s0 + e)) & 4095) * (1.0f / 4096.0f); v[e] = part ? __builtin_amdgcn_sinf(ph) : __builtin_amdgcn_cosf(ph); }
            v4u o; o.x = pk2(v[0], v[1]); o.y = pk2(v[2], v[3]); o.z = pk2(v[4], v[5]); o.w = pk2(v[6], v[7]);
            *(v4u*)(ADFT + (size_t)m * 2048 + s0) = o;
        }
        for (long t = gtid; t < 4096 * 16; t += NGT) {
            const int pos = (int)(t >> 4), j = (int)(t & 15);
            double rev = (double)pos * INVF[j] * 0.15915494309189535; rev -= floor(rev);
            const float r = (float)rev; rope[2 * t] = __builtin_amdgcn_cosf(r); rope[2 * t + 1] = __builtin_amdgcn_sinf(r);
        }
    }
    SEAM(0);

    REP(1) if (IN(1)) {
        pg8::Gemm g{XG, WIN, M, INW, DM}; pg8::StaticOrder S; S.init(M, INW, G, bx);
        pg8::EpiZ E{Qb, Kb, Vb, Fb, GAb, GFb, inv0, rope};
        pg8::gemm_phase<pg8::EpiZ, pg8::StaticOrder, true, true>(glds, g, S, E);
    }
    SEAM(1);

    REP(2) if (IN(2)) {
        {
            LAS unsigned short* t16 = (LAS unsigned short*)((LAS unsigned char*)lds + wave * 16384);
            for (int t = gw; t < 2048; t += NGW) {
                const int par = t & 1, tt = t >> 1, sbp = tt >> 3, nb = tt & 7, b = sbp >> 5, s0 = (sbp & 31) * 64, r0 = b * 4096 + s0;
                const float sg = par ? -1.0f : 1.0f;
#pragma unroll
                for (int i = 0; i < 8; ++i) { const int row = (lane >> 3) + 8 * i, ch = lane & 7;
                    const v4u lo4 = *(const v4u*)(Fb + (size_t)(r0 + row) * 512 + nb * 64 + ch * 8), hi4 = *(const v4u*)(Fb + (size_t)(r0 + 2048 + row) * 512 + nb * 64 + ch * 8);
                    v4u v;
#define ED(C) v.C = pk2(pg8::bflo(lo4.C) + sg * pg8::bflo(hi4.C), pg8::bfhi(lo4.C) + sg * pg8::bfhi(hi4.C))
                    ED(x); ED(y); ED(z); ED(w);
#undef ED
                    LAS unsigned short* d = t16 + (ch * 8) * 66 + row;
                    d[0 * 66] = (unsigned short)(v.x & 0xffffu); d[1 * 66] = (unsigned short)(v.x >> 16); d[2 * 66] = (unsigned short)(v.y & 0xffffu); d[3 * 66] = (unsigned short)(v.y >> 16);
                    d[4 * 66] = (unsigned short)(v.z & 0xffffu); d[5 * 66] = (unsigned short)(v.z >> 16); d[6 * 66] = (unsigned short)(v.w & 0xffffu); d[7 * 66] = (unsigned short)(v.w >> 16); }
                LDS_WAIT(); asm volatile("" ::: "memory");
                const LAS unsigned* rp = (const LAS unsigned*)(t16 + lane * 66);
                bf16* orow = FT + ((size_t)(par * 2048 + b * 512 + nb * 64 + lane)) * 2048 + s0;
#pragma unroll
                for (int j = 0; j < 8; ++j) { v4u o; o.x = rp[4 * j]; o.y = rp[4 * j + 1]; o.z = rp[4 * j + 2]; o.w = rp[4 * j + 3]; *(v4u*)(orow + 8 * j) = o; }
                LDS_WAIT(); asm volatile("" ::: "memory");
            }
            __syncthreads();
        }
        for (int i = 0;; ++i) {
            const int u = i * G + vcu; if (u >= 1536) break;
            const int qb = u & 31, grp = u >> 5, c = grp & 1, h = (grp >> 1) % NH, b = grp / (2 * NH);
            const att::bf16* Qp = (const att::bf16*)Qb + ((size_t)b * SEQ + qb * 128) * QKW + (h * 2 + c) * 128;
            const att::bf16* Kp = (const att::bf16*)Kb + ((size_t)b * SEQ) * QKW + (h * 2 + c) * 128;
            const att::bf16* Vp = (const att::bf16*)Vb + ((size_t)b * SEQ) * VW + h * 256;
            att::bf16* Op = (att::bf16*)OPC + ((size_t)b * SEQ + qb * 128) * 3072 + (h * 2 + c) * 256;
            att::attn_pc_unit(Qp, Kp, Vp, Op, (char*)lds, (2 * qb) & 63);
        }
    }
    SEAM(2);

    REP(3) if (IN(3)) {
        const int Gd = G / 2;
        constexpr int R1 = 13312;
        int c_start, c_end, c_stride;
        if (bx < Gd) {
            pg8::Gemm g{ADFT, FT, 4096, 4096, 2048}; pg8::DftOrder S; S.S0.init(4096, 2048, Gd, bx);
            pg8::EpiDft E{Gb};
            pg8::gemm_phase<pg8::EpiDft, pg8::DftOrder, true, true>(glds, g, S, E);
            c_start = R1 + bx * NWAVES + wave; c_end = M; c_stride = Gd * NWAVES;
        } else {
            const int gw2 = (bx - Gd) * NWAVES + wave, NGW2 = (G - Gd) * NWAVES;
            for (int n = gw2; n < 2048; n += NGW2) {
                const bf16* fr_ = FT + (size_t)n * 2048; float a = 0.f;
#pragma unroll
                for (int j = 0; j < 4; ++j) { const v4u w = *((const v4u*)(fr_ + j * 512) + lane);
                    a += (pg8::bflo(w.x) - pg8::bfhi(w.x)) + (pg8::bflo(w.y) - pg8::bfhi(w.y)) + (pg8::bflo(w.z) - pg8::bfhi(w.z)) + (pg8::bflo(w.w) - pg8::bfhi(w.w)); }
                a = wave_sum(a);
                if (lane == 0) { bf16* gp = Gb + ((size_t)(n >> 9) * 4096 + 2048) * 1024 + (n & 511); gp[0] = (bf16)f2bf(a); gp[512] = 0; }
            }
            for (int t = gw2; t < 1024; t += NGW2) {
                const int nchunk = t & 7, dblk = (t >> 3) & 15, g = (t >> 7) & 3, part = t >> 9, n = nchunk * 256 + lane * 4;
                f32x4 a[8];
    #pragma unroll
                for (int dd = 0; dd < 8; ++dd) a[dd] = (f32x4){0.f, 0.f, 0.f, 0.f};
                const float* wp = w_four + (size_t)(g * 128) * DM + n;
    #pragma unroll 2
                for (int c = 0; c < 128; ++c) { const f32x4 w = *(const f32x4*)(wp + (size_t)c * DM);
    #pragma unroll
                    for (int dd = 0; dd < 8; ++dd) { const float ph = (float)(((dblk * 8 + dd) * c) & 127) * (1.0f / 128.0f);
                        const float tv = part ? __builtin_amdgcn_sinf(ph) : __builtin_amdgcn_cosf(ph); a[dd] += w * tv; } }
                const float sc = (part ? -1.0f : 1.0f) * 0.0013810679320049755f;
    #pragma unroll
                for (int q = 0; q < 4; ++q) { v4u o; o.x = pk2(a[0][q] * sc, a[1][q] * sc); o.y = pk2(a[2][q] * sc, a[3][q] * sc); o.z = pk2(a[4][q] * sc, a[5][q] * sc); o.w = pk2(a[6][q] * sc, a[7][q] * sc);
                    *(v4u*)(WCS + (size_t)(n + q) * 1024 + part * 512 + g * 128 + dblk * 8) = o; }
            }
            c_start = gw2; c_end = R1; c_stride = NGW2;
        }
        float lam;
        { const float a1 = lq1[lane] * lk1[lane] + lq1[lane + 64] * lk1[lane + 64], a2 = lq2[lane] * lk2[lane] + lq2[lane + 64] * lk2[lane + 64];
          lam = expf(wave_sum(a1)) - expf(wave_sum(a2)) + LAMBDA_INIT; }
        const f32x4 gs = *((const f32x4*)g_subln + lane);
        for (int row = c_start; row < c_end; row += c_stride) {
            v2u a[NH], b2[NH];
#pragma unroll
            for (int h = 0; h < NH; ++h) { a[h] = *((const v2u*)(OPC + (size_t)row * 3072 + (2 * h) * 256) + lane); b2[h] = *((const v2u*)(OPC + (size_t)row * 3072 + (2 * h + 1) * 256) + lane); }
#pragma unroll
            for (int h = 0; h < NH; ++h) {
                f32x4 d; d.x = pg8::bflo(a[h].x) - lam * pg8::bflo(b2[h].x); d.y = pg8::bfhi(a[h].x) - lam * pg8::bfhi(b2[h].x); d.z = pg8::bflo(a[h].y) - lam * pg8::bflo(b2[h].y); d.w = pg8::bfhi(a[h].y) - lam * pg8::bfhi(b2[h].y);
                const float ss = wave_sum((d.x * d.x + d.y * d.y) + (d.z * d.z + d.w * d.w));
                const float sc = (1.0f - LAMBDA_INIT) / sqrtf(ss * (1.0f / 256.0f) + RMS_EPS);
                v2u w; w.x = pk2(d.x * sc * gs.x, d.y * sc * gs.y); w.y = pk2(d.z * sc * gs.z, d.w * sc * gs.w);
                *((v2u*)(Ob + (size_t)row * VW + h * 256) + lane) = w;
            }
        }
    }
    SEAM(3);

    REP(4) if (IN(4)) {
        pg8::Gemm g{Ob, WA, M, DM, VW}; pg8::StaticOrder S; S.init(M, DM, G, bx);
        pg8::EpiGateA E{GAb, P1};
        pg8::gemm_phase<pg8::EpiGateA, pg8::StaticOrder, true, true>(glds, g, S, E);
    }
    REP(5) if (IN(5)) {
        pg8::Gemm g{Gb, WCS, M, DM, 1024}; pg8::StaticOrder S; S.init(M, DM, G, bx);
        pg8::EpiGateF E{GFb, P1, MG};
        pg8::gemm_phase<pg8::EpiGateF, pg8::StaticOrder, true, true>(glds, g, S, E);
    }
    SEAM(5);

    REP(6) if (IN(6)) {
        pg8::Gemm g{MG, WOUT, M, DM, DM}; pg8::StaticOrder S; S.init(M, DM, G, bx);
        pg8::EpiRes<true> E{x, args.out, X1G, g_ffn, ss1};
        pg8::gemm_phase<pg8::EpiRes<true>, pg8::StaticOrder, true, true>(glds, g, S, E);
    }
    SEAM(6);

    REP(7) if (IN(7)) {
        pg8::Gemm g{X1G, WGU, M, 2 * DFF, DM}; pg8::StaticOrder S; S.init(M, 2 * DFF, G, bx);
        pg8::EpiSwiGLU E{Ub, ss1};
        pg8::gemm_phase<pg8::EpiSwiGLU, pg8::StaticOrder, true, true>(glds, g, S, E);
    }
    SEAM(7);

    REP(8) if (IN(8)) {
        pg8::Gemm g{Ub, WDN, M, DM, DFF}; pg8::StaticOrder S; S.init(M, DM, G, bx);
        pg8::EpiRes2 E{X1G, g_ffn, ss2};
        pg8::gemm_phase<pg8::EpiRes2, pg8::StaticOrder, true, true>(glds, g, S, E);
    }
    SEAM(8);

    REP(9) if (IN(9)) {
        for (int m = gw; m < M; m += NGW) {
            const float rs = 1.0f / sqrtf(ss2[m] * (1.0f / DM) + RMS_EPS);
            const v4u* xr = (const v4u*)(X1G + (size_t)m * DM) + lane; f32x4* orow = (f32x4*)(args.out + (size_t)m * DM); const f32x4* g4 = (const f32x4*)g_final;
            v4u q[4];
#pragma unroll
            for (int j = 0; j < 4; ++j) q[j] = xr[64 * j];
#pragma unroll
            for (int j = 0; j < 4; ++j) { const int c4 = (64 * j + lane) * 2;
                const f32x4 a = (f32x4){pg8::bflo(q[j].x), pg8::bfhi(q[j].x), pg8::bflo(q[j].y), pg8::bfhi(q[j].y)}, b2 = (f32x4){pg8::bflo(q[j].z), pg8::bfhi(q[j].z), pg8::bflo(q[j].w), pg8::bfhi(q[j].w)};
                orow[c4] = a * rs * g4[c4]; orow[c4 + 1] = b2 * rs * g4[c4 + 1]; }
        }
    }
#undef IN
#undef SEAM
}

#if defined(MK_PROBE)
__global__ void __launch_bounds__(256) probe_kernel(float* out, const unsigned char* ws) {
    const bf16* Ob = (const bf16*)(ws + WS_O); const bf16* MG = (const bf16*)(ws + WS_MG); const bf16* GFb = (const bf16*)(ws + WS_GF); const bf16* X1G = (const bf16*)(ws + WS_X1G);
    for (size_t i = (size_t)blockIdx.x * 256 + threadIdx.x; i < (size_t)M * DM; i += (size_t)gridDim.x * 256) {
        const size_t m = i / DM; const int c = (int)(i % DM); float v = 0.f;
#if MK_PROBE == 1
        if (c < 1536) v = __uint_as_float((unsigned)Ob[m * 1536 + c] << 16);
#elif MK_PROBE == 2
        v = __uint_as_float((unsigned)MG[m * 2048 + c] << 16);
#elif MK_PROBE == 3
        v = __uint_as_float((unsigned)GFb[m * 2048 + c] << 16);
#elif MK_PROBE == 6
        v = __uint_as_float((unsigned)((const bf16*)(ws + WS_P1))[m * 2048 + c] << 16);
#elif MK_PROBE == 5
        if (c < 1024) v = __uint_as_float((unsigned)((const bf16*)(ws + WS_V))[m * 1024 + c] << 16);
#elif MK_PROBE == 7
        { const bf16* FTp = (const bf16*)(ws + WS_FT); const size_t j = (size_t)i % ((size_t)2048 * 4096); v = __uint_as_float((unsigned)FTp[j] << 16); }
#elif MK_PROBE == 8
        if (c < 1024) v = __uint_as_float((unsigned)GFb[m * 2048 + c] << 16); else if (m < 2048) v = 1000.f * __uint_as_float((unsigned)((const bf16*)(ws + WS_WCS))[m * 1024 + (c - 1024)] << 16);
#elif MK_PROBE == 9
        v = __uint_as_float((unsigned)((const bf16*)(ws + WS_GA))[m * 2048 + c] << 16);
#elif MK_PROBE == 4
        v = __uint_as_float((unsigned)X1G[m * 2048 + c] << 16);
#endif
        out[i] = v; }
}
#endif
extern "C" void kernel_launch(void* const* d_in, const int* in_sizes, int n_in, void* d_out, int out_size, void* d_ws, size_t ws_size, hipStream_t stream) {
    static int grid = 0;
    if (grid == 0) {
        if (n_in != 16 || in_sizes[0] != M * DM || out_size != M * DM || ws_size < WS_END) {
            fprintf(stderr, "kernel_launch: unexpected shapes: n_in %d in0 %d out %d ws %zu (need >= %zu)\n", n_in, n_in > 0 ? in_sizes[0] : -1, out_size, ws_size, (size_t)WS_END); grid = -1; return; }
        int dev = 0, cus = 0, per_cu = 0;
        if (hipGetDevice(&dev) != hipSuccess || hipDeviceGetAttribute(&cus, hipDeviceAttributeMultiprocessorCount, dev) != hipSuccess) { grid = -1; return; }
        if (hipFuncSetAttribute((const void*)mk_fwd, hipFuncAttributeMaxDynamicSharedMemorySize, LDS_BYTES) != hipSuccess) { fprintf(stderr, "kernel_launch: hipFuncSetAttribute failed\n"); grid = -1; return; }
        if (hipOccupancyMaxActiveBlocksPerMultiprocessor(&per_cu, (const void*)mk_fwd, NTHREADS, LDS_BYTES) != hipSuccess || per_cu < 1) { fprintf(stderr, "kernel_launch: occupancy query says %d\n", per_cu); (void)hipGetLastError(); per_cu = 1; }
        grid = cus * per_cu;
    }
    if (grid < 0) return;
    Args a{};
    for (int i = 0; i < 16; ++i) a.in[i] = (const float*)d_in[i];
    a.out = (float*)d_out; a.ws = (unsigned char*)d_ws;
#ifndef MK_RMASK
#define MK_RMASK 0x3ff
#endif
    a.rmask = MK_RMASK;
#if MK_PER_PHASE
    for (int ph = 0; ph < NPHASES; ++ph) { a.ph_lo = ph; a.ph_hi = ph + 1; hipLaunchKernelGGL(mk_fwd, dim3(grid), dim3(NTHREADS), LDS_BYTES, stream, a); }
#if defined(MK_PROBE)
    hipLaunchKernelGGL(probe_kernel, dim3(2048), dim3(256), 0, stream, (float*)d_out, (const unsigned char*)d_ws);
#endif
#else
    a.ph_lo = 0; a.ph_hi = NPHASES;
    void* kargs[] = {(void*)&a};
    hipError_t e = hipLaunchCooperativeKernel((const void*)mk_fwd, dim3(grid), dim3(NTHREADS), kargs, LDS_BYTES, stream);
    if (e != hipSuccess) fprintf(stderr, "kernel_launch: cooperative launch failed: %s (grid %d)\n", hipGetErrorString(e), grid);
#endif
}
```
